# Optimizing an MI355X kernel written in HIP

```python
import math
import jax
import jax.numpy as jnp
from jax import lax
import numpy as np

D_MODEL = 1024
BATCH = 32
SEQ = 2048
DEPTH = 2

D_MIX = D_MODEL
S5_WIDTH = D_MIX // 2
S5_GROUP_CH = 16
S5_GROUPS = S5_WIDTH // S5_GROUP_CH
S5_STATE = 64
S5_CHUNK = 128
GLA_WIDTH = D_MIX - S5_WIDTH
GLA_HEADS = 4
GLA_DK = GLA_WIDTH // 2
GLA_HEAD_K = GLA_DK // GLA_HEADS
GLA_HEAD_V = GLA_WIDTH // GLA_HEADS
GLA_GATE_RANK = 16
GLA_GATE_TAU = 16.0
GLA_CHUNK = 64
IN_SPLITS = (S5_WIDTH, S5_WIDTH + GLA_DK, S5_WIDTH + 2 * GLA_DK, S5_WIDTH + 2 * GLA_DK + GLA_WIDTH, S5_WIDTH + 2 * GLA_DK + 2 * GLA_WIDTH)
IN_COLS = S5_WIDTH + 2 * GLA_DK + 2 * GLA_WIDTH + GLA_GATE_RANK
D_FF = 7 * D_MODEL // 2
N_EXPERTS = 8
TOP_K = 2
N_DENSE = (DEPTH + 1) // 2
N_MOE = DEPTH // 2
DN_ALPHA = (2.0 * DEPTH) ** 0.25
DN_BETA = (8.0 * DEPTH) ** -0.25
N_MOD = 6
MOD_STD = 0.1
LN_EPS = 1e-5
RMS_EPS = 1e-6

kernel_name = 'hymba_s5_gla_deepnorm_moe_trunk'


def _layer_norm(x, gain, bias):
    xf = x.astype(jnp.float32)
    mu = jnp.mean(xf, axis=-1, keepdims=True)
    var = jnp.mean(jnp.square(xf - mu), axis=-1, keepdims=True)
    return ((xf - mu) * lax.rsqrt(var + LN_EPS)).astype(x.dtype) * gain + bias


def _rms_norm(x, gain):
    xf = x.astype(jnp.float32)
    return xf * lax.rsqrt(jnp.mean(xf * xf, axis=-1, keepdims=True) + RMS_EPS) * gain.astype(jnp.float32)


def _linear_recurrence_op(e1, e2):
    a1, b1 = e1
    a2, b2 = e2
    return a1 * a2, a2 * b1 + b2


def _s5_group(u, lam_re, lam_im, log_dt, b_re, b_im, c_re, c_im, d_skip, w_glu, b_glu):
    bsz, seq, _ = u.shape
    n_chunks = seq // S5_CHUNK
    f32 = jnp.float32
    uf = u.astype(f32)
    lam = lax.complex(lam_re.astype(f32), lam_im.astype(f32))
    dt = jnp.exp(log_dt.astype(f32))[:, None]
    lam_bar = jnp.exp(lam * dt)
    b_mat = lax.complex(b_re.astype(f32), b_im.astype(f32))
    b_bar = ((lam_bar - 1.0) / lam)[:, :, None] * b_mat
    c_mat = lax.complex(c_re.astype(f32), c_im.astype(f32))
    u_chunks = uf.reshape(bsz, n_chunks, S5_CHUNK, S5_GROUPS, S5_GROUP_CH).transpose(1, 0, 2, 3, 4)
    a_elems = jnp.broadcast_to(lam_bar, (bsz, S5_CHUNK, S5_GROUPS, S5_STATE))

    def chunk_step(h, u_c):
        bu = jnp.einsum('gph,blgh->blgp', b_bar, u_c.astype(jnp.complex64))
        a_cum, s = lax.associative_scan(_linear_recurrence_op, (a_elems, bu), axis=1)
        states = s + a_cum * h[:, None]
        y = jnp.einsum('ghp,blgp->blgh', c_mat, states).real
        return states[:, -1], y

    h0 = jnp.zeros((bsz, S5_GROUPS, S5_STATE), jnp.complex64)
    _, y = lax.scan(chunk_step, h0, u_chunks)
    y = y.transpose(1, 0, 2, 3, 4).reshape(bsz, seq, S5_WIDTH) + d_skip.astype(f32) * uf
    y = jax.nn.gelu(y).astype(u.dtype)
    return y * jax.nn.sigmoid(y @ w_glu + b_glu)


def _gla_group(q, k, v, g_out, a_low, w_alpha_up, b_alpha, head_gain):
    bsz, seq, _ = q.shape
    nc = seq // GLA_CHUNK
    f32 = jnp.float32

    def heads(t, dh):
        return t.astype(f32).reshape(bsz, nc, GLA_CHUNK, GLA_HEADS, dh).transpose(1, 0, 3, 2, 4)

    log_alpha = jax.nn.log_sigmoid((a_low @ w_alpha_up + b_alpha).astype(f32)) / GLA_GATE_TAU
    qc = heads(q, GLA_HEAD_K) * (GLA_HEAD_K ** -0.5)
    kc = heads(k, GLA_HEAD_K)
    vc = heads(v, GLA_HEAD_V)
    bc = jnp.cumsum(heads(log_alpha, GLA_HEAD_K), axis=3)
    causal = jnp.tril(jnp.ones((GLA_CHUNK, GLA_CHUNK), dtype=bool))

    def chunk_step(state, inp):
        q_c, k_c, v_c, b_c = inp
        o_inter = jnp.einsum('bhik,bhkv->bhiv', q_c * jnp.exp(b_c), state)
        diff = b_c[:, :, :, None, :] - b_c[:, :, None, :, :]
        decay = jnp.exp(jnp.where(causal[:, :, None], diff, -jnp.inf))
        scores = jnp.einsum('bhik,bhjk,bhijk->bhij', q_c, k_c, decay)
        o_intra = jnp.einsum('bhij,bhjv->bhiv', scores, v_c)
        b_last = b_c[:, :, -1:, :]
        k_dec = k_c * jnp.exp(b_last - b_c)
        new_state = jnp.exp(b_last[:, :, 0, :])[..., None] * state + jnp.einsum('bhjk,bhjv->bhkv', k_dec, v_c)
        return new_state, o_inter + o_intra

    s0 = jnp.zeros((bsz, GLA_HEADS, GLA_HEAD_K, GLA_HEAD_V), f32)
    _, o = lax.scan(chunk_step, s0, (qc, kc, vc, bc))
    o = o.transpose(1, 0, 3, 2, 4).reshape(bsz, seq, GLA_HEADS, GLA_HEAD_V)
    o = _rms_norm(o, head_gain.reshape(GLA_HEADS, GLA_HEAD_V)).reshape(bsz, seq, GLA_WIDTH)
    return (o * jax.nn.silu(g_out.astype(f32))).astype(q.dtype)


def _swiglu(x, w_gate, w_up, w_down):
    return (jax.nn.silu(x @ w_gate) * (x @ w_up)) @ w_down


def _moe_swiglu(x, w_router, b_router, w_gate, w_up, w_down):
    logits = (x @ w_router).astype(jnp.float32) + b_router.astype(jnp.float32)
    top_vals, top_idx = lax.top_k(logits, TOP_K)
    top_w = jax.nn.softmax(top_vals, axis=-1)
    combine = jnp.sum(jax.nn.one_hot(top_idx, N_EXPERTS, dtype=jnp.float32) * top_w[..., None], axis=-2)
    out = jnp.zeros_like(x)
    for e in range(N_EXPERTS):
        out = out + combine[..., e:e + 1].astype(x.dtype) * _swiglu(x, w_gate[e], w_up[e], w_down[e])
    return out


def setup_inputs(seed: int = 0) -> dict:
    key = jax.random.key(seed)
    ks = jax.random.split(key, 32)
    f32 = jnp.float32

    def nrm(k, shape, std):
        return std * jax.random.normal(k, shape, f32)

    G, P, H = S5_GROUPS, S5_STATE, S5_GROUP_CH
    return {
        'x': jax.random.normal(ks[0], (BATCH, SEQ, D_MODEL), f32),
        'c': jax.random.normal(ks[1], (BATCH, D_MODEL), f32),
        'mod_w': nrm(ks[2], (DEPTH, D_MODEL, N_MOD * D_MODEL), MOD_STD * D_MODEL ** -0.5),
        'mod_b': nrm(ks[3], (DEPTH, N_MOD * D_MODEL), 0.01),
        'w_in': nrm(ks[4], (DEPTH, D_MODEL, IN_COLS), D_MODEL ** -0.5),
        'w_out': nrm(ks[5], (DEPTH, D_MIX, D_MODEL), DN_BETA * D_MIX ** -0.5),
        's5_lam_re': -0.5 * jnp.exp(nrm(ks[6], (DEPTH, G, P), 0.05)),
        's5_lam_im': math.pi * jnp.arange(P, dtype=f32)[None, None, :] + nrm(ks[7], (DEPTH, G, P), 0.01),
        's5_log_dt': jax.random.uniform(ks[8], (DEPTH, G), f32, math.log(1e-3), math.log(1e-1)),
        's5_b_re': nrm(ks[9], (DEPTH, G, P, H), (2.0 * H) ** -0.5),
        's5_b_im': nrm(ks[10], (DEPTH, G, P, H), (2.0 * H) ** -0.5),
        's5_c_re': nrm(ks[11], (DEPTH, G, H, P), (2.0 * P) ** -0.5),
        's5_c_im': nrm(ks[12], (DEPTH, G, H, P), (2.0 * P) ** -0.5),
        's5_d': nrm(ks[13], (DEPTH, S5_WIDTH), 1.0),
        's5_w_glu': nrm(ks[14], (DEPTH, S5_WIDTH, S5_WIDTH), S5_WIDTH ** -0.5),
        's5_b_glu': nrm(ks[15], (DEPTH, S5_WIDTH), 0.01),
        'gla_w_alpha_up': nrm(ks[16], (DEPTH, GLA_GATE_RANK, GLA_DK), GLA_GATE_RANK ** -0.5),
        'gla_b_alpha': nrm(ks[17], (DEPTH, GLA_DK), 0.01),
        'gla_head_gain': 1.0 + nrm(ks[18], (DEPTH, GLA_WIDTH), 0.02),
        'ln_mix_g': 1.0 + nrm(ks[19], (DEPTH, D_MODEL), 0.02),
        'ln_mix_b': nrm(ks[20], (DEPTH, D_MODEL), 0.01),
        'ffn_w_gate': nrm(ks[21], (N_DENSE, D_MODEL, D_FF), D_MODEL ** -0.5),
        'ffn_w_up': nrm(ks[22], (N_DENSE, D_MODEL, D_FF), D_MODEL ** -0.5),
        'ffn_w_down': nrm(ks[23], (N_DENSE, D_FF, D_MODEL), DN_BETA * D_FF ** -0.5),
        'moe_w_router': nrm(ks[24], (N_MOE, D_MODEL, N_EXPERTS), D_MODEL ** -0.5),
        'moe_b_router': nrm(ks[25], (N_MOE, N_EXPERTS), 0.01),
        'moe_w_gate': nrm(ks[26], (N_MOE, N_EXPERTS, D_MODEL, D_FF), D_MODEL ** -0.5),
        'moe_w_up': nrm(ks[27], (N_MOE, N_EXPERTS, D_MODEL, D_FF), D_MODEL ** -0.5),
        'moe_w_down': nrm(ks[28], (N_MOE, N_EXPERTS, D_FF, D_MODEL), DN_BETA * D_FF ** -0.5),
        'ln_ffn_g': 1.0 + nrm(ks[29], (DEPTH, D_MODEL), 0.02),
        'ln_ffn_b': nrm(ks[30], (DEPTH, D_MODEL), 0.01),
    }


def reference(x, c, mod_w, mod_b, w_in, w_out, s5_lam_re, s5_lam_im, s5_log_dt, s5_b_re, s5_b_im, s5_c_re, s5_c_im, s5_d, s5_w_glu, s5_b_glu, gla_w_alpha_up, gla_b_alpha, gla_head_gain, ln_mix_g, ln_mix_b, ffn_w_gate, ffn_w_up, ffn_w_down, moe_w_router, moe_b_router, moe_w_gate, moe_w_up, moe_w_down, ln_ffn_g, ln_ffn_b):
    c_act = jax.nn.silu(c)
    for layer in range(DEPTH):
        mod = c_act @ mod_w[layer] + mod_b[layer]
        sh_m, sc_m, gt_m, sh_f, sc_f, gt_f = jnp.split(mod[:, None, :], N_MOD, axis=-1)
        h = x * (1 + sc_m) + sh_m
        u, q, k, v, g_out, a_low = jnp.split(h @ w_in[layer], IN_SPLITS, axis=-1)
        y_s5 = _s5_group(u, s5_lam_re[layer], s5_lam_im[layer], s5_log_dt[layer], s5_b_re[layer], s5_b_im[layer], s5_c_re[layer], s5_c_im[layer], s5_d[layer], s5_w_glu[layer], s5_b_glu[layer])
        y_gla = _gla_group(q, k, v, g_out, a_low, gla_w_alpha_up[layer], gla_b_alpha[layer], gla_head_gain[layer])
        y = jnp.concatenate([y_s5, y_gla], axis=-1) @ w_out[layer]
        x = _layer_norm(DN_ALPHA * x + (1 + gt_m) * y, ln_mix_g[layer], ln_mix_b[layer])
        h = x * (1 + sc_f) + sh_f
        i = layer // 2
        if layer % 2 == 0:
            f = _swiglu(h, ffn_w_gate[i], ffn_w_up[i], ffn_w_down[i])
        else:
            f = _moe_swiglu(h, moe_w_router[i], moe_b_router[i], moe_w_gate[i], moe_w_up[i], moe_w_down[i])
        x = _layer_norm(DN_ALPHA * x + (1 + gt_f) * f, ln_ffn_g[layer], ln_ffn_b[layer])
    return x
```

```cpp
#include <hip/hip_runtime.h>
#include <cstdio>
#include <cstdint>

#ifndef PH_MASK
#define PH_MASK 0xFFFF
#endif
#define PH(k) ((PH_MASK >> (k)) & 1)
#ifndef GLA_REPS
#define GLA_REPS 1
#endif
#ifndef GLA_PROD_REPS
#define GLA_PROD_REPS 1
#endif
#ifndef REP_MASK
#define REP_MASK 0
#endif
#define REPS(k) (((REP_MASK >> (k)) & 1) ? 2 : 1)
#ifndef MK_N_LAUNCHES
#define MK_N_LAUNCHES 1
#endif

constexpr int D = 1024, BATCH = 32, SEQ = 2048, M = BATCH * SEQ, DEPTH = 2;
constexpr int S5W = 512, S5G = 32, S5H = 16, S5P = 64, S5T = 32;
constexpr int S5NC = SEQ / S5T;
constexpr int S5ROWS = BATCH * S5NC;
constexpr int S5KU = S5T * S5H;
constexpr int S5LDA = S5KU + 2 * S5P;
constexpr int GDK = 256, GHK = 64, GHV = 128, GNH = 4, GRANK = 16, GCH = 64, GW = 512;
constexpr int INCOLS = 2064, NIN = 2304;
constexpr int DFF = 3584, NE = 8;
constexpr float LN_EPS = 1e-5f, RMS_EPS = 1e-6f;
constexpr float DN_ALPHA = 1.41421356237309515f;
constexpr int NMOD = 6;
constexpr int NWAVES = 8;

constexpr size_t MiB = 1u << 20;
constexpr size_t WS_CTL = 0, CTL_ZERO_BYTES = 64 * 1024;
constexpr size_t WS_MOD = 1 * MiB;
constexpr size_t WS_TOKE = 3 * MiB;
constexpr size_t WS_TOKP0 = WS_TOKE + 256 * 1024, WS_TOKP1 = WS_TOKP0 + 256 * 1024;
constexpr size_t WS_TOKW0 = WS_TOKP1 + 256 * 1024, WS_TOKW1 = WS_TOKW0 + 256 * 1024;
constexpr size_t WS_WGCNT = WS_TOKW1 + 256 * 1024;
constexpr size_t WS_PANEL = WS_WGCNT + 16 * 1024;
constexpr size_t WS_LAMT = WS_PANEL + 16 * 1024;
constexpr size_t WS_S2T = 8 * MiB;
constexpr size_t WS_SA = 9 * MiB;
constexpr size_t WS_SW = 10 * MiB;
constexpr size_t WS_SAS = 12 * MiB;
constexpr size_t WS_SWIN = 11 * MiB;
constexpr size_t WS_WMOE = 16 * MiB;
constexpr size_t WMOE_E = 21 * MiB, WMOE_D = 14 * MiB;
constexpr size_t WS_WIN = 184 * MiB;
constexpr size_t WS_WOUT = WS_WIN + 9 * MiB;
constexpr size_t WS_WGLU = WS_WOUT + 4 * MiB;
constexpr size_t WS_WDEN = WS_WGLU + 1 * MiB;
constexpr size_t WS_CTRL = WS_WDEN + 21 * MiB;
constexpr size_t WS_TOEP = WS_CTRL + 16 * MiB;
static_assert(WS_TOEP + 40 * MiB <= 280 * MiB, "static region");
constexpr size_t WS_R8 = 344 * MiB;
constexpr size_t WS_HMOD = 280 * MiB;
constexpr size_t WS_AEXT = 408 * MiB;
constexpr size_t WS_Q = 488 * MiB, WS_K = 520 * MiB, WS_V = 552 * MiB, WS_GO = 616 * MiB;
constexpr size_t WS_LA = 680 * MiB;
constexpr size_t WS_YS5 = 744 * MiB;
constexpr size_t WS_YCAT = 808 * MiB;
constexpr size_t WS_SLOC = 936 * MiB;
constexpr size_t WS_F = 408 * MiB;
constexpr size_t WS_FD = 632 * MiB;
constexpr size_t WS_H8 = 280 * MiB;
constexpr size_t WS_ACT = 668 * MiB;
constexpr size_t WS_END = 1024 * MiB;
static_assert(WS_SLOC + 32 * MiB <= WS_END && WS_ACT + (size_t)264 * 256 * DFF <= WS_END && WS_F + (size_t)520 * 256 * D * 2 <= WS_ACT, "ws map");
constexpr int CW_SUB = 8192;
constexpr int CW_BAR = 4096;
constexpr int SLICE_P = 256;

constexpr int RING_BYTES = 131072;
constexpr int LDSCTL_OFF = RING_BYTES, MISC_OFF = LDSCTL_OFF + 320;
constexpr int LDS_BYTES = 147456;

#define GAS __attribute__((address_space(1)))
#define LAS __attribute__((address_space(3)))
typedef unsigned short bf16;
typedef unsigned v4u __attribute__((ext_vector_type(4)));
typedef unsigned v2u __attribute__((ext_vector_type(2)));
typedef float f32x4 __attribute__((ext_vector_type(4)));
typedef float f32x2 __attribute__((ext_vector_type(2)));
typedef short bf16x8 __attribute__((ext_vector_type(8)));
#define LDS_WAIT() asm volatile("s_waitcnt lgkmcnt(0)" ::: "memory")
#define VM_WAIT() asm volatile("s_waitcnt vmcnt(0)" ::: "memory")
__device__ __forceinline__ unsigned f2bf(float f) { unsigned u = __builtin_bit_cast(unsigned, f); return (u + 0x7fffu + ((u >> 16) & 1u)) >> 16; }
typedef __bf16 bf16v2_t __attribute__((ext_vector_type(2)));
__device__ __forceinline__ unsigned pk2(float lo, float hi) { const f32x2 v = {lo, hi}; const bf16v2_t b = __builtin_convertvector(v, bf16v2_t); return __builtin_bit_cast(unsigned, b); }
__device__ __forceinline__ float frcp(float x) { return __builtin_amdgcn_rcpf(x); }
__device__ __forceinline__ float frsq(float x) { return __builtin_amdgcn_rsqf(x); }
__device__ __forceinline__ float bflo(unsigned w) { return __builtin_bit_cast(float, w << 16); }
__device__ __forceinline__ float bfhi(unsigned w) { return __builtin_bit_cast(float, w & 0xffff0000u); }
__device__ __forceinline__ float bf2f(bf16 h) { return __builtin_bit_cast(float, ((unsigned)h) << 16); }
#define DPP_F(v, ctrl, rmask) __builtin_bit_cast(float, __builtin_amdgcn_update_dpp(0, __builtin_bit_cast(int, (v)), (ctrl), (rmask), 0xF, false))
__device__ __forceinline__ float wave_sum(float v) {
    v += DPP_F(v, 0xB1, 0xF);
    v += DPP_F(v, 0x4E, 0xF);
    v += DPP_F(v, 0x141, 0xF);
    v += DPP_F(v, 0x140, 0xF);
    v += DPP_F(v, 0x142, 0xA);
    v += DPP_F(v, 0x143, 0xC);
    return __builtin_bit_cast(float, __builtin_amdgcn_readlane(__builtin_bit_cast(int, v), 63));
}
#ifndef Q8_EMU
#define Q8_EMU 0
#endif
__device__ __forceinline__ float q8emu(float x, float s) {
    if (!Q8_EMU) return x;
    float y = x * s; const float a = fabsf(y);
    if (a >= 0.015625f) { unsigned u = __builtin_bit_cast(unsigned, y); u = (u + 0x7FFFFu + ((u >> 20) & 1u)) & ~0xFFFFFu; y = __builtin_bit_cast(float, u); }
    else y = rintf(y * 512.0f) * (1.0f / 512.0f);
    y = fminf(fmaxf(y, -448.f), 448.f);
    return y / s;
}
__device__ __forceinline__ float sigmoidf_(float x) { return frcp(1.0f + __expf(-x)); }
__device__ __forceinline__ float siluf_(float x) { return x * frcp(1.0f + __expf(-x)); }
__device__ __forceinline__ float gelu_tanh(float x) {
    const float a2 = x * x * (-2.0f * 0.7978845608028654f * 0.044715f * 1.4426950408889634f) + (-2.0f * 0.7978845608028654f * 1.4426950408889634f);
    return x * frcp(1.0f + __builtin_amdgcn_exp2f(x * a2));
}

__device__ __forceinline__ float wave_max_nonneg(float v) {
    v = __builtin_fmaxf(v, DPP_F(v, 0xB1, 0xF)); v = __builtin_fmaxf(v, DPP_F(v, 0x4E, 0xF)); v = __builtin_fmaxf(v, DPP_F(v, 0x141, 0xF)); v = __builtin_fmaxf(v, DPP_F(v, 0x140, 0xF));
    v = __builtin_fmaxf(v, DPP_F(v, 0x142, 0xA)); v = __builtin_fmaxf(v, DPP_F(v, 0x143, 0xC));
    return __builtin_bit_cast(float, __builtin_amdgcn_readlane(__builtin_bit_cast(int, v), 63));
}
__device__ __forceinline__ unsigned pk4_i8(float a, float b, float c, float d) {
    const int ia = (int)__builtin_rintf(a), ib = (int)__builtin_rintf(b), ic = (int)__builtin_rintf(c), id = (int)__builtin_rintf(d);
    return ((unsigned)ia & 0xffu) | (((unsigned)ib & 0xffu) << 8) | (((unsigned)ic & 0xffu) << 16) | ((unsigned)id << 24);
}
namespace pg8 {
#define PG8_LAS __attribute__((address_space(3)))
typedef unsigned short bf16_t;
constexpr int BM = 256, BK = 64, HALF = 128, HTB = HALF * BK * 2, STAGE_BYTES = 8 * HTB, NXCD = 8, WGM = 8;
__host__ __device__ __forceinline__ int lds_byte(int r, int c) { const int st = (r >> 4) * 2 + (c >> 5), rr = r & 15, cc = c & 31, ob = rr * 64 + cc * 2; return st * 1024 + (ob ^ (((ob >> 9) & 1) << 5)); }
__host__ __device__ __forceinline__ void stage_rc(int b, int& R, int& C) { const int st = b / 1024, sb = b % 1024, swz = sb ^ (((sb >> 9) & 1) << 5); R = (st >> 1) * 16 + swz / 64; C = (st & 1) * 32 + (swz % 64) / 2; }
__host__ __device__ __forceinline__ int perm32(int rho) { const int n = rho >> 4, i = rho & 15; return 8 * (i >> 2) + 4 * n + (i & 3); }

struct Unit { const char* a; const char* b; int pm, pn; const int* rows; };
struct Gemm { int K; unsigned a_row, a_grp, a_kstep, ldb; };
__device__ __forceinline__ Gemm mk_gemm(int K, int lda, int ldb) { return Gemm{K, (unsigned)lda * 2u, 32u, 128u, (unsigned)ldb}; }

__device__ __forceinline__ void tile_of(int L, int nM, int nN, int& pm, int& pn) {
    const int nwg = nM * nN; int wgid = L;
    { const int q = nwg / NXCD, r = nwg % NXCD, xcd = wgid % NXCD, off = wgid / NXCD; wgid = (xcd < r ? xcd * (q + 1) : r * (q + 1) + (xcd - r) * q) + off; }
    const int nig = WGM * nN, gid = wgid / nig, fm = gid * WGM, gsz = (nM - fm) < WGM ? (nM - fm) : WGM;
    pm = fm + ((wgid % nig) % gsz); pn = (wgid % nig) / gsz;
}

typedef int i32x4 __attribute__((ext_vector_type(4)));
typedef int i32x8 __attribute__((ext_vector_type(8)));
template <class Epi, class Sched, bool ALIGN_EPI = true, bool SP2 = true, bool FP8 = false, bool GATHER = false, bool I8 = false>
__device__ __forceinline__ void gemm_phase(PG8_LAS unsigned char* lds, const Gemm g, const Sched& S, Epi& E, const int tid) {
    const int wid = __builtin_amdgcn_readfirstlane(tid >> 6), lane = tid & 63, wr = wid >> 2, wc = wid & 3, fr = lane & 15, fq = lane >> 4;
    const int K = g.K, nt = K / BK;
    unsigned voffA[2], voffB[2]; int rowA[2]; unsigned colA[2];
#pragma unroll
    for (int i = 0; i < 2; ++i) { int R, C; stage_rc(tid * 16 + i * 8192, R, C); const int Rb = Epi::PERM ? ((R & ~31) + perm32(R & 31)) : R;
        rowA[i] = R; colA[i] = (unsigned)(C >> 4) * g.a_grp + (unsigned)(C & 15) * 2u;
        voffA[i] = (unsigned)R * g.a_row + colA[i]; voffB[i] = (unsigned)(Rb * (int)g.ldb + C) * 2u; }
    unsigned vA[2][2], nvA[2][2];
#define PG8_GIDX(dst, unit) do { _Pragma("unroll") for (int _h = 0; _h < 2; ++_h) _Pragma("unroll") for (int _i = 0; _i < 2; ++_i) dst[_h][_i] = (unsigned)(unit).rows[_h * HALF + rowA[_i]] * g.a_row + colA[_i]; } while (0)
#define PG8_STAGE_A(bufoff, gbase, h, nx) do { if constexpr (GATHER) { unsigned _vo[2] = {(nx) ? nvA[h][0] : vA[h][0], (nx) ? nvA[h][1] : vA[h][1]}; PG8_STAGE(bufoff, gbase, _vo); } \
        else { PG8_STAGE(bufoff, (gbase) + (h) * hstepA, voffA); } } while (0)
    constexpr unsigned kstepB = BK * 2; const unsigned kstepA = g.a_kstep;
    const unsigned hstepA = (unsigned)HALF * g.a_row, hstepB = (unsigned)HALF * g.ldb * 2u;
    const unsigned ldsw = (unsigned)wid * 1024u;
    int one_e8m0 = 0x7F7F7F7F; asm volatile("" : "+v"(one_e8m0));
    (void)one_e8m0;
    const unsigned ldsbase = (unsigned)__builtin_amdgcn_readfirstlane((int)(unsigned)(size_t)lds) + ldsw;
    const int aoff = lds_byte(wr * 64 + fr, fq * 8), boff = lds_byte(wc * 32 + fr, fq * 8);
#define PG8_SA(b, h) (((b) * 2 + (h)) * HTB)
#define PG8_SB(b, h) ((4 + (b) * 2 + (h)) * HTB)
#define PG8_STAGE(bufoff, gbase, voff) do { _Pragma("unroll") for (int _i = 0; _i < 2; ++_i) { unsigned _keep; \
        asm volatile("s_mov_b32 %0, m0\n\ts_mov_b32 m0, %1\n\ts_nop 0\n\tglobal_load_lds_dwordx4 %2, %3\n\ts_mov_b32 m0, %0" : "=&s"(_keep) : "s"(ldsbase + (unsigned)((bufoff) + _i * 8192)), "v"((voff)[_i]), "s"((const char*)(gbase)) : "memory"); } } while (0)
#define PG8_CAT(x0, x1) __builtin_shufflevector((x0), (x1), 0, 1, 2, 3, 4, 5, 6, 7)
#define PG8_LDA(dst, b, h) do { _Pragma("unroll") for (int m = 0; m < 4; ++m) { if constexpr (FP8) dst##_8[m] = PG8_CAT(*(const PG8_LAS i32x4*)(lds + PG8_SA(b, h) + aoff + m * 2048), *(const PG8_LAS i32x4*)(lds + PG8_SA(b, h) + aoff + m * 2048 + 1024)); \
        else { _Pragma("unroll") for (int k = 0; k < 2; ++k) dst[m][k] = *(const PG8_LAS bf16x8*)(lds + PG8_SA(b, h) + aoff + m * 2048 + k * 1024); } } } while (0)
#define PG8_LDB(dst, b, h) do { _Pragma("unroll") for (int n = 0; n < 2; ++n) { if constexpr (FP8) dst##_8[n] = PG8_CAT(*(const PG8_LAS i32x4*)(lds + PG8_SB(b, h) + boff + n * 2048), *(const PG8_LAS i32x4*)(lds + PG8_SB(b, h) + boff + n * 2048 + 1024)); \
        else { _Pragma("unroll") for (int k = 0; k < 2; ++k) dst[n][k] = *(const PG8_LAS bf16x8*)(lds + PG8_SB(b, h) + boff + n * 2048 + k * 1024); } } } while (0)
#define PG8_MMA(ai, bj, At, Bt) do { __builtin_amdgcn_s_setprio(1); \
        if constexpr (FP8) { _Pragma("unroll") for (int m = 0; m < 4; ++m) _Pragma("unroll") for (int n = 0; n < 2; ++n) \
            acc[ai][bj][m][n] = __builtin_amdgcn_mfma_scale_f32_16x16x128_f8f6f4(Bt##_8[n], At##_8[m], acc[ai][bj][m][n], 0, 0, 0, one_e8m0, 0, one_e8m0); } \
        else if constexpr (I8) { _Pragma("unroll") for (int m = 0; m < 4; ++m) _Pragma("unroll") for (int n = 0; n < 2; ++n) _Pragma("unroll") for (int k = 0; k < 2; ++k) \
            acc[ai][bj][m][n] = __builtin_bit_cast(f32x4, __builtin_amdgcn_mfma_i32_16x16x64_i8(__builtin_bit_cast(i32x4, Bt[n][k]), __builtin_bit_cast(i32x4, At[m][k]), __builtin_bit_cast(i32x4, acc[ai][bj][m][n]), 0, 0, 0)); } \
        else { _Pragma("unroll") for (int m = 0; m < 4; ++m) _Pragma("unroll") for (int n = 0; n < 2; ++n) _Pragma("unroll") for (int k = 0; k < 2; ++k) \
            acc[ai][bj][m][n] = __builtin_amdgcn_mfma_f32_16x16x32_bf16(Bt[n][k], At[m][k], acc[ai][bj][m][n], 0, 0, 0); } \
        __builtin_amdgcn_s_setprio(0); } while (0)
#define PG8_WAIT_V(n) asm volatile("s_waitcnt vmcnt(" #n ")" ::: "memory")
#define PG8_WAIT_L(n) asm volatile("s_waitcnt lgkmcnt(" #n ")" ::: "memory")
#define PG8_BAR __builtin_amdgcn_s_barrier()
#define PG8_SCHED __builtin_amdgcn_sched_barrier(0)
    Unit cur, nxt; int ui = 0;
    if (!S.next(0, cur)) return;
    f32x4 acc[2][2][4][2];
#pragma unroll
    for (int a = 0; a < 2; ++a)
#pragma unroll
        for (int b = 0; b < 2; ++b)
#pragma unroll
            for (int m = 0; m < 4; ++m)
#pragma unroll
                for (int n = 0; n < 2; ++n) acc[a][b][m][n] = (f32x4){0.f, 0.f, 0.f, 0.f};
    bf16x8 At[4][2], B0[2][2], B1[2][2]; i32x8 At_8[4], B0_8[2], B1_8[2];
    const char* cA = cur.a; const char* cB = cur.b;
    if constexpr (GATHER) { PG8_GIDX(vA, cur); }
    if constexpr (SP2) {
        PG8_STAGE(PG8_SB(0, 0), cB, voffB); PG8_STAGE(PG8_SB(0, 1), cB + hstepB, voffB); PG8_STAGE_A(PG8_SA(0, 0), cA, 0, false); PG8_STAGE_A(PG8_SA(0, 1), cA, 1, false);
        if (wr == 1) PG8_BAR;
        PG8_WAIT_V(2); PG8_BAR;
        PG8_STAGE(PG8_SB(1, 0), cB + kstepB, voffB); PG8_STAGE_A(PG8_SA(1, 0), cA + kstepA, 0, false); PG8_STAGE(PG8_SB(1, 1), cB + hstepB + kstepB, voffB);
        PG8_WAIT_V(6); PG8_BAR;
    } else {
        PG8_STAGE(PG8_SB(0, 0), cB, voffB); PG8_STAGE_A(PG8_SA(0, 0), cA, 0, false); PG8_STAGE(PG8_SB(0, 1), cB + hstepB, voffB); PG8_STAGE_A(PG8_SA(0, 1), cA, 1, false);
        if (wr == 1) PG8_BAR;
        PG8_WAIT_V(4); PG8_BAR;
        PG8_STAGE(PG8_SB(1, 0), cB + kstepB, voffB); PG8_STAGE_A(PG8_SA(1, 0), cA + kstepA, 0, false); PG8_STAGE(PG8_SB(1, 1), cB + hstepB + kstepB, voffB);
        PG8_WAIT_V(6); PG8_BAR;
    }
    for (;;) {
        const bool has_next = S.next(ui + 1, nxt);
        const char* nA = has_next ? nxt.a : cA; const char* nB = has_next ? nxt.b : cB;
        int nidx[2][2];
        if constexpr (GATHER) { if (has_next) { _Pragma("unroll") for (int _h = 0; _h < 2; ++_h) _Pragma("unroll") for (int _i = 0; _i < 2; ++_i)
            asm volatile("global_load_dword %0, %1, %2" : "=v"(nidx[_h][_i]) : "v"((unsigned)(_h * HALF + rowA[_i]) * 4u), "s"(nxt.rows) : "memory"); } }
        int ntu = nt; bool ksk = false;
        if constexpr (Sched::KSKIP) { ksk = S.kskip(cur); if (ksk) ntu = nt - Sched::KS_N; }
        for (int t = 0; t < ntu; t += 2) {
            const bool last = (t == ntu - 2);
            if constexpr (GATHER) { if (last) { if (has_next) { asm volatile("" : "+v"(nidx[0][0]), "+v"(nidx[0][1]), "+v"(nidx[1][0]), "+v"(nidx[1][1]));
                    _Pragma("unroll") for (int _h = 0; _h < 2; ++_h) _Pragma("unroll") for (int _i = 0; _i < 2; ++_i) nvA[_h][_i] = (unsigned)nidx[_h][_i] * g.a_row + colA[_i]; }
                else { _Pragma("unroll") for (int _h = 0; _h < 2; ++_h) { nvA[_h][0] = vA[_h][0]; nvA[_h][1] = vA[_h][1]; } } } }
            int k1 = t + 1, k2 = t + 2;
            if constexpr (Sched::KSKIP) { if (ksk) { if (t >= Sched::KS_LO) k1 += Sched::KS_N; if (t + 2 >= Sched::KS_LO) k2 += Sched::KS_N; } }
            const char* a1 = cA + (unsigned)k1 * kstepA;
            const char* a2 = last ? nA : cA + (unsigned)k2 * kstepA; const char* b2 = last ? nB : cB + (unsigned)k2 * kstepB;
            const char* a3 = a2 + kstepA; const char* b3 = b2 + kstepB;
            if constexpr (SP2) {
            PG8_LDB(B0, 0, 0); PG8_LDB(B1, 0, 1); PG8_SCHED; PG8_LDA(At, 0, 0); PG8_STAGE_A(PG8_SA(1, 1), a1, 1, false);
            PG8_WAIT_V(8); PG8_WAIT_L(0); PG8_BAR; PG8_MMA(0, 0, At, B0); PG8_MMA(0, 1, At, B1); PG8_BAR; PG8_SCHED;
            PG8_LDA(At, 0, 1); PG8_STAGE(PG8_SB(0, 0), b2, voffB); PG8_STAGE(PG8_SB(0, 1), b2 + hstepB, voffB); PG8_STAGE_A(PG8_SA(0, 0), a2, 0, last);
            PG8_WAIT_V(8); PG8_WAIT_L(0); PG8_BAR; PG8_MMA(1, 0, At, B0); PG8_MMA(1, 1, At, B1); PG8_BAR; PG8_SCHED;
            PG8_LDB(B0, 1, 0); PG8_LDB(B1, 1, 1); PG8_SCHED; PG8_LDA(At, 1, 0); PG8_STAGE_A(PG8_SA(0, 1), a2, 1, last);
            PG8_WAIT_V(8); PG8_WAIT_L(0); PG8_BAR; PG8_MMA(0, 0, At, B0); PG8_MMA(0, 1, At, B1); PG8_BAR; PG8_SCHED;
            PG8_LDA(At, 1, 1); PG8_STAGE(PG8_SB(1, 0), b3, voffB); PG8_STAGE(PG8_SB(1, 1), b3 + hstepB, voffB); PG8_STAGE_A(PG8_SA(1, 0), a3, 0, last);
            PG8_WAIT_V(8); PG8_WAIT_L(0); PG8_BAR; PG8_MMA(1, 0, At, B0); PG8_MMA(1, 1, At, B1); PG8_BAR; PG8_SCHED;
            } else {
            PG8_LDB(B0, 0, 0); PG8_SCHED; PG8_LDA(At, 0, 0); PG8_STAGE_A(PG8_SA(1, 1), a1, 1, false);
            PG8_WAIT_L(8); PG8_BAR; PG8_WAIT_L(0); PG8_MMA(0, 0, At, B0); PG8_BAR; PG8_SCHED;
            PG8_LDB(B1, 0, 1); PG8_STAGE(PG8_SB(0, 0), b2, voffB);
            PG8_BAR; PG8_WAIT_L(0); PG8_MMA(0, 1, At, B1); PG8_BAR;
            PG8_LDA(At, 0, 1); PG8_STAGE_A(PG8_SA(0, 0), a2, 0, last);
            PG8_BAR; PG8_WAIT_L(0); PG8_MMA(1, 0, At, B0); PG8_BAR; PG8_SCHED;
            PG8_STAGE(PG8_SB(0, 1), b2 + hstepB, voffB);
            PG8_WAIT_V(6); PG8_BAR; PG8_MMA(1, 1, At, B1); PG8_BAR;
            PG8_LDB(B0, 1, 0); PG8_SCHED; PG8_LDA(At, 1, 0); PG8_STAGE_A(PG8_SA(0, 1), a2, 1, last);
            PG8_WAIT_L(8); PG8_BAR; PG8_WAIT_L(0); PG8_MMA(0, 0, At, B0); PG8_BAR; PG8_SCHED;
            PG8_LDB(B1, 1, 1); PG8_STAGE(PG8_SB(1, 0), b3, voffB);
            PG8_BAR; PG8_WAIT_L(0); PG8_MMA(0, 1, At, B1); PG8_BAR;
            PG8_LDA(At, 1, 1); PG8_STAGE_A(PG8_SA(1, 0), a3, 0, last);
            PG8_BAR; PG8_WAIT_L(0); PG8_MMA(1, 0, At, B0); PG8_BAR; PG8_SCHED;
            PG8_STAGE(PG8_SB(1, 1), b3 + hstepB, voffB);
            PG8_WAIT_V(6); PG8_BAR; PG8_MMA(1, 1, At, B1); PG8_BAR;
            }
        }
        if constexpr (ALIGN_EPI) { if (wr == 0) PG8_BAR; }
        E(acc, cur, wr, wc, fr, fq);
        if (!has_next) break;
#pragma unroll
        for (int a = 0; a < 2; ++a)
#pragma unroll
            for (int b = 0; b < 2; ++b)
#pragma unroll
                for (int m = 0; m < 4; ++m)
#pragma unroll
                    for (int n = 0; n < 2; ++n) acc[a][b][m][n] = (f32x4){0.f, 0.f, 0.f, 0.f};
        cur = nxt; cA = nA; cB = nB; ++ui;
        if constexpr (GATHER) { _Pragma("unroll") for (int _h = 0; _h < 2; ++_h) { vA[_h][0] = nvA[_h][0]; vA[_h][1] = nvA[_h][1]; } }
        if constexpr (ALIGN_EPI) { if (wr == 1) PG8_BAR; }
    }
    PG8_WAIT_V(0);
    if constexpr (!ALIGN_EPI) { if (wr == 0) PG8_BAR; }
    PG8_BAR;
#undef PG8_SA
#undef PG8_SB
#undef PG8_STAGE
#undef PG8_STAGE_A
#undef PG8_GIDX
#undef PG8_LDA
#undef PG8_LDB
#undef PG8_MMA
#undef PG8_CAT
#undef PG8_WAIT_V
#undef PG8_WAIT_L
#undef PG8_BAR
#undef PG8_SCHED
}

struct SchedPlain {
    static constexpr bool KSKIP = false;
    const char* A; const char* B; int nM, nN, G, c; unsigned astep, bstep;
    __device__ __forceinline__ bool next(int i, Unit& u) const { const int L = i * G + c; if (L >= nM * nN) return false; int pm, pn; tile_of(L, nM, nN, pm, pn);
        u.pm = pm; u.pn = pn; u.a = A + (unsigned)pm * astep; u.b = B + (unsigned)pn * bstep; u.rows = nullptr; return true; }
};
template <bool KSK>
struct SchedGroupT {
    static constexpr bool KSKIP = KSK; static constexpr int KS_LO = 4, KS_N = 4;
    const char* A; const char* B; int nM, nN, G, c; unsigned astep, bstep, gstep;
    __device__ __forceinline__ bool next(int i, Unit& u) const { const int L = i * G + c; if (L >= nM * nN) return false; int pm, pn; tile_of(L, nM, nN, pm, pn);
        if (KSK) pn ^= (i & 1);
        u.pm = pm; u.pn = pn; u.a = A + (unsigned)pm * astep; u.b = B + ((unsigned)(pm >> 3) * gstep + (unsigned)pn * bstep); u.rows = nullptr; return true; }
    __device__ __forceinline__ bool kskip(const Unit& u) const { return KSK && u.pn == 0; }
};
typedef SchedGroupT<false> SchedGroup;
typedef SchedGroupT<true> SchedGroupS5;
struct SchedExpert {
    static constexpr bool KSKIP = false;
    const char* A; const char* W; const int* pexp; int p0, nM, nN, G, c; unsigned astep, bstep, estep; int a_local; const int* s2t; int skipc, full_rounds;
    __device__ __forceinline__ bool next(int i, Unit& u) const {
        int L = i * G + c;
        if (skipc > 0 && i >= full_rounds) { if (c < skipc) return false; L = full_rounds * G + (i - full_rounds) * (G - skipc) + (c - skipc); }
        if (L >= nM * nN) return false; int pm, pn; tile_of(L, nM, nN, pm, pn);
        const int e = pexp ? __builtin_amdgcn_readfirstlane(pexp[p0 + pm]) : 0;
        u.pm = p0 + pm; u.pn = pn; u.a = s2t ? A : A + (unsigned)(a_local ? pm : p0 + pm) * astep; u.b = W + ((unsigned)e * estep + (unsigned)pn * bstep); u.rows = s2t ? s2t + (p0 + pm) * 256 : nullptr; return true; }
};

struct EpiInProj {
    static constexpr bool PERM = true;
    unsigned char* ws; const float* b_alpha; const float* sa; const float* sw;
    static __device__ __forceinline__ f32x4 dq(const f32x4& a, const float rs, const f32x4& cs) { const i32x4 ai = __builtin_bit_cast(i32x4, a); return (f32x4){(float)ai[0] * (rs * cs[0]), (float)ai[1] * (rs * cs[1]), (float)ai[2] * (rs * cs[2]), (float)ai[3] * (rs * cs[3])}; }
    static __device__ __forceinline__ f32x4 dq1(const f32x4& a, const float c) { const i32x4 ai = __builtin_bit_cast(i32x4, a); return (f32x4){(float)ai[0] * c, (float)ai[1] * c, (float)ai[2] * c, (float)ai[3] * c}; }
    __device__ __forceinline__ void operator()(const f32x4 (&acc)[2][2][4][2], const Unit& u, int wr, int wc, int fr, int fq) const {
        const int pn = u.pn;
        f32x4 cs[2][2]; float rsv[2][4];
#pragma unroll
        for (int bj = 0; bj < 2; ++bj) { const float* p = sw + pn * 256 + bj * HALF + wc * 32 + 8 * fq; cs[bj][0] = *(const f32x4*)p; cs[bj][1] = *(const f32x4*)(p + 4); }
#pragma unroll
        for (int ai = 0; ai < 2; ++ai)
#pragma unroll
            for (int m = 0; m < 4; ++m) rsv[ai][m] = sa[u.pm * BM + ai * HALF + wr * 64 + m * 16 + fr];
        if (pn == 8) {
            bf16* la = (bf16*)(ws + WS_LA);
#pragma unroll
            for (int bj = 0; bj < 2; ++bj) {
                const int cl = bj * HALF + wc * 32 + 8 * fq;
                const f32x4 b0 = *(const f32x4*)(b_alpha + cl), b1 = *(const f32x4*)(b_alpha + cl + 4);
#pragma unroll
                for (int ai = 0; ai < 2; ++ai)
#pragma unroll
                    for (int m = 0; m < 4; ++m) {
                        const int R = u.pm * BM + ai * HALF + wr * 64 + m * 16 + fr;
                        bf16* o = la + (size_t)R * GDK + cl;
                        const float rs = rsv[ai][m]; const f32x4 v0 = dq(acc[ai][bj][m][0], rs, cs[bj][0]), v1 = dq(acc[ai][bj][m][1], rs, cs[bj][1]);
                        f32x4 r0, r1;
#pragma unroll
                        for (int j = 0; j < 4; ++j) { const float x0 = v0[j] + b0[j], x1 = v1[j] + b1[j];
                            r0[j] = (fminf(x0, 0.f) - __logf(1.0f + __expf(-fabsf(x0)))) * (1.0f / 16.0f); r1[j] = (fminf(x1, 0.f) - __logf(1.0f + __expf(-fabsf(x1)))) * (1.0f / 16.0f); }
                        *(v4u*)o = (v4u){pk2(r0[0], r0[1]), pk2(r0[2], r0[3]), pk2(r1[0], r1[1]), pk2(r1[2], r1[3])};
                        asm volatile("" ::: "memory");
                    }
            }
        } else if (pn < 2) {
            bf16* aext = (bf16*)(ws + WS_AEXT);
#pragma unroll
            for (int ai = 0; ai < 2; ++ai)
#pragma unroll
                for (int m = 0; m < 4; ++m) {
                    const int R = u.pm * BM + ai * HALF + wr * 64 + m * 16 + fr, b = R >> 11, t = R & 2047;
                    bf16* rowp = aext + ((size_t)(b * S5NC + (t >> 5)) * S5LDA + (t & 31) * 16); const float rs = rsv[ai][m];
#pragma unroll
                    for (int bj = 0; bj < 2; ++bj) {
                        const int ch = pn * 256 + bj * HALF + wc * 32 + 8 * fq, g = ch >> 4, h8 = ch & 8;
                        const float c = rs * cs[bj][0][0]; const f32x4 v0 = dq1(acc[ai][bj][m][0], c), v1 = dq1(acc[ai][bj][m][1], c);
                        v4u w; w.x = pk2(v0[0], v0[1]); w.y = pk2(v0[2], v0[3]); w.z = pk2(v1[0], v1[1]); w.w = pk2(v1[2], v1[3]);
                        *(v4u*)(rowp + (size_t)g * S5ROWS * S5LDA + h8) = w;
                    }
                    asm volatile("" ::: "memory");
                }
        } else {
            bf16* base; int ldc, c0;
            if (pn == 2) { base = (bf16*)(ws + WS_Q); ldc = GDK; c0 = 0; } else if (pn == 3) { base = (bf16*)(ws + WS_K); ldc = GDK; c0 = 0; }
            else if (pn < 6) { base = (bf16*)(ws + WS_V); ldc = GW; c0 = (pn - 4) * 256; } else { base = (bf16*)(ws + WS_GO); ldc = GW; c0 = (pn - 6) * 256; }
#pragma unroll
            for (int ai = 0; ai < 2; ++ai)
#pragma unroll
                for (int m = 0; m < 4; ++m) { const int R = u.pm * BM + ai * HALF + wr * 64 + m * 16 + fr; bf16* rowp = base + (size_t)R * ldc + c0 + wc * 32 + 8 * fq; const float rs = rsv[ai][m];
#pragma unroll
                    for (int bj = 0; bj < 2; ++bj) { const float c = rs * cs[bj][0][0]; const f32x4 v0 = dq1(acc[ai][bj][m][0], c), v1 = dq1(acc[ai][bj][m][1], c);
                        v4u w; w.x = pk2(v0[0], v0[1]); w.y = pk2(v0[2], v0[3]); w.z = pk2(v1[0], v1[1]); w.w = pk2(v1[2], v1[3]);
                        *(v4u*)(rowp + bj * HALF) = w; }
                    asm volatile("" ::: "memory"); }
        }
    }
};
struct EpiS1 {
    static constexpr bool PERM = false;
    float* sloc;
    __device__ __forceinline__ void operator()(const f32x4 (&acc)[2][2][4][2], const Unit& u, int wr, int wc, int fr, int fq) const {
#pragma unroll
        for (int ai = 0; ai < 2; ++ai)
#pragma unroll
            for (int m = 0; m < 4; ++m) { float* rowp = sloc + (size_t)(u.pm * BM + ai * HALF + wr * 64 + m * 16 + fr) * 128 + wc * 32 + 4 * fq;
#pragma unroll
                for (int n = 0; n < 2; ++n) *(f32x4*)(rowp + n * 16) = acc[ai][0][m][n]; }
    }
};
struct EpiS5 {
    static constexpr bool PERM = true;
    const bf16* aext; const float* dskip; bf16* ys5;
    __device__ __forceinline__ void operator()(const f32x4 (&acc)[2][2][4][2], const Unit& u, int wr, int wc, int fr, int fq) const {
        const int g = u.pm >> 3;
#pragma unroll
        for (int bj = 0; bj < 2; ++bj) {
            const int c = u.pn * 256 + bj * HALF + wc * 32 + 8 * fq, h8 = c & 8;
            const f32x4 d0 = *(const f32x4*)(dskip + g * 16 + h8), d1 = *(const f32x4*)(dskip + g * 16 + h8 + 4);
            v4u uv[2][4];
#pragma unroll
            for (int ai = 0; ai < 2; ++ai)
#pragma unroll
                for (int m = 0; m < 4; ++m) uv[ai][m] = *(const v4u*)(aext + (size_t)(u.pm * BM + ai * HALF + wr * 64 + m * 16 + fr) * S5LDA + c);
#pragma unroll
            for (int ai = 0; ai < 2; ++ai)
#pragma unroll
                for (int m = 0; m < 4; ++m) {
                    const int rho = u.pm * BM + ai * HALF + wr * 64 + m * 16 + fr;
                    const v4u uu = uv[ai][m];
                    const f32x4 v0 = acc[ai][bj][m][0], v1 = acc[ai][bj][m][1];
                    float y[8];
                    y[0] = v0[0] + d0[0] * bflo(uu.x); y[1] = v0[1] + d0[1] * bfhi(uu.x); y[2] = v0[2] + d0[2] * bflo(uu.y); y[3] = v0[3] + d0[3] * bfhi(uu.y);
                    y[4] = v1[0] + d1[0] * bflo(uu.z); y[5] = v1[1] + d1[1] * bfhi(uu.z); y[6] = v1[2] + d1[2] * bflo(uu.w); y[7] = v1[3] + d1[3] * bfhi(uu.w);
#pragma unroll
                    for (int j = 0; j < 8; ++j) y[j] = gelu_tanh(y[j]);
                    v4u w; w.x = pk2(y[0], y[1]); w.y = pk2(y[2], y[3]); w.z = pk2(y[4], y[5]); w.w = pk2(y[6], y[7]);
                    *(v4u*)(ys5 + (size_t)rho * S5W + c) = w;
                }
            asm volatile("" ::: "memory");
        }
    }
};
struct EpiGlu {
    static constexpr bool PERM = true;
    const bf16* ys5; const float* bglu; bf16* ycat;
    __device__ __forceinline__ void operator()(const f32x4 (&acc)[2][2][4][2], const Unit& u, int wr, int wc, int fr, int fq) const {
#pragma unroll
        for (int bj = 0; bj < 2; ++bj) {
            const int c = u.pn * 256 + bj * HALF + wc * 32 + 8 * fq;
            const f32x4 b0 = *(const f32x4*)(bglu + c), b1 = *(const f32x4*)(bglu + c + 4);
            v4u yv[2][4];
#pragma unroll
            for (int ai = 0; ai < 2; ++ai)
#pragma unroll
                for (int m = 0; m < 4; ++m) yv[ai][m] = *(const v4u*)(ys5 + ((size_t)(c >> 4) * M + (u.pm * BM + ai * HALF + wr * 64 + m * 16 + fr)) * 16 + (c & 15));
#pragma unroll
            for (int ai = 0; ai < 2; ++ai)
#pragma unroll
                for (int m = 0; m < 4; ++m) {
                    const int R = u.pm * BM + ai * HALF + wr * 64 + m * 16 + fr;
                    const v4u yy = yv[ai][m];
                    const f32x4 v0 = acc[ai][bj][m][0], v1 = acc[ai][bj][m][1];
                    v4u w;
                    w.x = pk2(bflo(yy.x) * sigmoidf_(v0[0] + b0[0]), bfhi(yy.x) * sigmoidf_(v0[1] + b0[1]));
                    w.y = pk2(bflo(yy.y) * sigmoidf_(v0[2] + b0[2]), bfhi(yy.y) * sigmoidf_(v0[3] + b0[3]));
                    w.z = pk2(bflo(yy.z) * sigmoidf_(v1[0] + b1[0]), bfhi(yy.z) * sigmoidf_(v1[1] + b1[1]));
                    w.w = pk2(bflo(yy.w) * sigmoidf_(v1[2] + b1[2]), bfhi(yy.w) * sigmoidf_(v1[3] + b1[3]));
                    *(v4u*)(ycat + (size_t)R * D + c) = w;
                }
            asm volatile("" ::: "memory");
        }
    }
};
struct EpiPlain {
    static constexpr bool PERM = true;
    bf16* out; int ldc; float scale;
    __device__ __forceinline__ void operator()(const f32x4 (&acc)[2][2][4][2], const Unit& u, int wr, int wc, int fr, int fq) const {
#pragma unroll
        for (int ai = 0; ai < 2; ++ai)
#pragma unroll
            for (int m = 0; m < 4; ++m) { bf16* rowp = out + (size_t)(u.pm * BM + ai * HALF + wr * 64 + m * 16 + fr) * ldc + u.pn * 256 + wc * 32 + 8 * fq;
#pragma unroll
                for (int bj = 0; bj < 2; ++bj) { const f32x4 v0 = acc[ai][bj][m][0] * scale, v1 = acc[ai][bj][m][1] * scale;
                    v4u w; w.x = pk2(v0[0], v0[1]); w.y = pk2(v0[2], v0[3]); w.z = pk2(v1[0], v1[1]); w.w = pk2(v1[2], v1[3]);
                    *(v4u*)(rowp + bj * HALF) = w; } }
    }
};
constexpr float ACT_SCALE = 16.f, WD_SCALE = 256.f;
__device__ __forceinline__ float clamp448(float x) { return __builtin_fminf(__builtin_fmaxf(x, -448.f), 448.f); }
__device__ __forceinline__ unsigned pk4_fp8(float a, float b, float c, float d) { int w = 0; w = __builtin_amdgcn_cvt_pk_fp8_f32(clamp448(a), clamp448(b), w, false); w = __builtin_amdgcn_cvt_pk_fp8_f32(clamp448(c), clamp448(d), w, true); return (unsigned)w; }
struct EpiGateUpI8 {
    static constexpr bool PERM = true;
    unsigned char* act; int p0; const float* sa; const int* s2t; const float* swb;
    const int* pexp;
    __device__ __forceinline__ void operator()(const f32x4 (&acc)[2][2][4][2], const Unit& u, int wr, int wc, int fr, int fq) const {
        const int e = pexp ? __builtin_amdgcn_readfirstlane(pexp[u.pm]) : 0;
        const float* sw = swb + (size_t)e * (2 * DFF) + u.pn * 256 + wc * 32 + 8 * fq;
        const float sg = sw[0], su = sw[128] * ACT_SCALE;
        float rsv[2][4];
#pragma unroll
        for (int ai = 0; ai < 2; ++ai)
#pragma unroll
            for (int m = 0; m < 4; ++m) rsv[ai][m] = sa[u.pm * BM + ai * HALF + wr * 64 + m * 16 + fr];
#pragma unroll
        for (int ai = 0; ai < 2; ++ai)
#pragma unroll
            for (int mp = 0; mp < 2; ++mp) { v2u wab[2];
#pragma unroll
                for (int q = 0; q < 2; ++q) { const int m = 2 * mp + q;
                    const float rs = rsv[ai][m];
                    const i32x4 gi0 = __builtin_bit_cast(i32x4, acc[ai][0][m][0]), gi1 = __builtin_bit_cast(i32x4, acc[ai][0][m][1]), ui0 = __builtin_bit_cast(i32x4, acc[ai][1][m][0]), ui1 = __builtin_bit_cast(i32x4, acc[ai][1][m][1]);
                    float g[8], uu[8];
                    const float cg = rs * sg, cu = rs * su;
#pragma unroll
                    for (int j = 0; j < 4; ++j) { g[j] = (float)gi0[j] * cg; g[4 + j] = (float)gi1[j] * cg; uu[j] = (float)ui0[j] * cu; uu[4 + j] = (float)ui1[j] * cu; }
                    wab[q].x = pk4_fp8(siluf_(g[0]) * uu[0], siluf_(g[1]) * uu[1], siluf_(g[2]) * uu[2], siluf_(g[3]) * uu[3]);
                    wab[q].y = pk4_fp8(siluf_(g[4]) * uu[4], siluf_(g[5]) * uu[5], siluf_(g[6]) * uu[6], siluf_(g[7]) * uu[7]); }
                const auto sx = __builtin_amdgcn_permlane16_swap(wab[0].x, wab[1].x, false, false), sy = __builtin_amdgcn_permlane16_swap(wab[0].y, wab[1].y, false, false);
                const int rl = ai * HALF + wr * 64 + (2 * mp + (fq & 1)) * 16 + fr;
                unsigned char* rowp = act + (size_t)((u.pm - p0) * BM + rl) * DFF + u.pn * 128 + wc * 32 + 8 * (fq & 2);
                *(v4u*)rowp = (v4u){sx[0], sy[0], sx[1], sy[1]};
                asm volatile("" ::: "memory"); }
    }
};
struct EpiGateUp {
    static constexpr bool PERM = true;
    unsigned char* act; int p0;
    __device__ __forceinline__ void operator()(const f32x4 (&acc)[2][2][4][2], const Unit& u, int wr, int wc, int fr, int fq) const {
#pragma unroll
        for (int ai = 0; ai < 2; ++ai)
#pragma unroll
            for (int m = 0; m < 4; ++m) { unsigned char* rowp = act + (size_t)((u.pm - p0) * BM + ai * HALF + wr * 64 + m * 16 + fr) * DFF + u.pn * 128 + wc * 32 + 8 * fq;
                const f32x4 g0 = acc[ai][0][m][0], g1 = acc[ai][0][m][1], u0 = acc[ai][1][m][0] * ACT_SCALE, u1 = acc[ai][1][m][1] * ACT_SCALE;
                v2u w; w.x = pk4_fp8(siluf_(g0[0]) * u0[0], siluf_(g0[1]) * u0[1], siluf_(g0[2]) * u0[2], siluf_(g0[3]) * u0[3]);
                w.y = pk4_fp8(siluf_(g1[0]) * u1[0], siluf_(g1[1]) * u1[1], siluf_(g1[2]) * u1[2], siluf_(g1[3]) * u1[3]);
                *(v2u*)rowp = w; }
    }
};
}

#define XB_TMO      128
#define XB_XCNT(j)  (256  + 64 * (j))
#define XB_XSUB(j)  (1280 + 64 * (j))
#define XB_XGEN(j)  (2304 + 64 * (j))
#define XB_TOP      3328
#define XB_TOPGEN   3392
#define XCD_BAR_WORDS 3456
#define XB_SPIN_CAP (1u << 18)
__device__ __forceinline__ unsigned xb_ld(unsigned* p)              { return __hip_atomic_load(p, __ATOMIC_RELAXED, __HIP_MEMORY_SCOPE_AGENT); }
__device__ __forceinline__ unsigned xb_add(unsigned* p, unsigned v) { return __hip_atomic_fetch_add(p, v, __ATOMIC_RELAXED, __HIP_MEMORY_SCOPE_AGENT); }
__device__ __forceinline__ unsigned xb_xcc_id() { return (unsigned)__builtin_amdgcn_s_getreg((3 << 11) | 20) & 0xFu; }
#define XB_SPIN(cond, bar) do { unsigned _sp = 0; while (cond) { __builtin_amdgcn_s_sleep(1); \
    if ((++_sp & 255u) == 0u) { if (xb_ld(&(bar)[XB_TMO])) break; if (_sp > XB_SPIN_CAP) { atomicAdd(&(bar)[XB_TMO], 1u); break; } } } } while (0)
struct XcdBarrier { unsigned* bar; unsigned x; volatile LAS unsigned* st; };
__device__ __forceinline__ XcdBarrier xcd_barrier_post(unsigned* bar, volatile LAS unsigned* st) {
    XcdBarrier b; b.bar = bar; b.x = xb_xcc_id(); b.st = st;
    if (threadIdx.x == 0) (void)xb_add(&bar[XB_XCNT(b.x)], 1u);
    return b;
}
__device__ __forceinline__ void xcd_barrier_complete(unsigned* bar, unsigned x, unsigned& nloc, unsigned& nx) {
    const unsigned G = gridDim.x * gridDim.y * gridDim.z;
    unsigned sum, cnt, mine, sp = 0u;
    for (;;) {
        sum = 0u; cnt = 0u; mine = 0u;
#pragma unroll
        for (unsigned j = 0; j < 16; ++j) { const unsigned c = xb_ld(&bar[XB_XCNT(j)]); sum += c; cnt += (c > 0u) ? 1u : 0u; mine = (j == x) ? c : mine; }
        if (sum == G) break;
        __builtin_amdgcn_s_sleep(1);
        if ((++sp & 255u) == 0u) { if (xb_ld(&bar[XB_TMO])) break; if (sp > XB_SPIN_CAP) { atomicAdd(&bar[XB_TMO], 1u); break; } }
    }
    nloc = mine > 0u ? mine : 1u; nx = cnt > 0u ? cnt : 1u;
}
__device__ __forceinline__ void xcd_barrier(const XcdBarrier& b) {
    asm volatile("s_waitcnt vmcnt(0)" ::: "memory");
    __syncthreads();
    if (threadIdx.x == 0) {
        unsigned* bar = b.bar;
        __builtin_amdgcn_s_waitcnt(0);
        unsigned nloc = b.st[0], nx = b.st[1];
        if (nloc == 0u) { xcd_barrier_complete(bar, b.x, nloc, nx); b.st[0] = nloc; b.st[1] = nx; }
        const unsigned old = xb_add(&bar[XB_XSUB(b.x)], 1u);
        const unsigned gen = old / nloc;
        if (old + 1u == (gen + 1u) * nloc) {
            __builtin_amdgcn_fence(__ATOMIC_RELEASE, "agent");
            asm volatile("s_waitcnt vmcnt(0)" ::: "memory");
            const unsigned og = xb_add(&bar[XB_TOP], 1u);
            const unsigned tg = og / nx;
            if (og + 1u == (tg + 1u) * nx) xb_add(&bar[XB_TOPGEN], 1u);
            else XB_SPIN(xb_ld(&bar[XB_TOPGEN]) == tg, bar);
            __builtin_amdgcn_fence(__ATOMIC_ACQUIRE, "agent");
            xb_add(&bar[XB_XGEN(b.x)], 1u);
            asm volatile("s_waitcnt vmcnt(0)" ::: "memory");
        } else {
            XB_SPIN(xb_ld(&bar[XB_XGEN(b.x)]) == gen, bar);
            __builtin_amdgcn_fence(__ATOMIC_ACQUIRE, "agent");
            asm volatile("s_waitcnt vmcnt(0)" ::: "memory");
        }
    }
    __syncthreads();
}

__device__ __forceinline__ void sub_barrier(unsigned* cnt, unsigned n, unsigned* bar) {
    asm volatile("s_waitcnt vmcnt(0)" ::: "memory");
    __syncthreads();
    if (threadIdx.x == 0) {
        __builtin_amdgcn_fence(__ATOMIC_RELEASE, "agent");
        asm volatile("s_waitcnt vmcnt(0)" ::: "memory");
        (void)xb_add(cnt, 1u);
        XB_SPIN(xb_ld(cnt) < n, bar);
        __builtin_amdgcn_fence(__ATOMIC_ACQUIRE, "agent");
        asm volatile("s_waitcnt vmcnt(0)" ::: "memory");
    }
    __syncthreads();
}

struct Args { const float* in[31]; float* out; unsigned char* ws; int lo, hi; };
static_assert(sizeof(Args) == 31 * 8 + 8 + 8 + 8, "Args has no padding");
#define CAS __attribute__((address_space(4)))
typedef const CAS Args* ArgP;
__device__ __forceinline__ int opaque_v(int x) { asm volatile("" : "+v"(x)); return x; }
__device__ __forceinline__ int opaque_s(int x) { asm volatile("" : "+s"(x)); return x; }
__device__ __forceinline__ int lane_id_volatile() { int x; asm volatile("v_mbcnt_lo_u32_b32 %0, -1, 0\n\tv_mbcnt_hi_u32_b32 %0, -1, %0" : "=v"(x)); return x; }
__device__ __forceinline__ ArgP argp() { ArgP p = (ArgP)__builtin_amdgcn_kernarg_segment_ptr(); asm volatile("" : "+s"(p)); return p; }
enum { I_X = 0, I_C, I_MODW, I_MODB, I_WIN, I_WOUT, I_LRE, I_LIM, I_LDT, I_BRE, I_BIM, I_CRE, I_CIM, I_SD, I_WGLU, I_BGLU, I_WAUP, I_BALPHA, I_GAIN, I_LNMG, I_LNMB,
       I_FG, I_FU, I_FD, I_RW, I_RB, I_MG, I_MU, I_MD, I_LNFG, I_LNFB };

constexpr int TP_RS = 68;
__device__ __forceinline__ void transpose_item(const float* W, int K, int ldw, bf16* WT, int kb, int n0, int drow0, LAS unsigned char* scr, int lane, float qs = 0.f) {
    const int k0 = 64 * kb;
    const float* src = W + (size_t)k0 * ldw + n0 + lane;
    float v[64];
#pragma unroll
    for (int kk = 0; kk < 64; ++kk) v[kk] = src[(size_t)kk * ldw];
    LAS unsigned* row = (LAS unsigned*)(scr + lane * (TP_RS * 2));
#pragma unroll
    for (int kk = 0; kk < 64; kk += 2) { const float a0 = (qs > 0.f) ? q8emu(v[kk], qs) : v[kk], a1 = (qs > 0.f) ? q8emu(v[kk + 1], qs) : v[kk + 1]; row[kk >> 1] = pk2(a0, a1); }
    LDS_WAIT(); asm volatile("" ::: "memory");
    const int c = lane & 7, r = lane >> 3;
#pragma unroll
    for (int i = 0; i < 8; ++i) { const int n = r + 8 * i; const LAS v2u* p = (const LAS v2u*)(scr + n * (TP_RS * 2) + c * 16); const v2u lo = p[0], hi = p[1];
        *(GAS v4u*)(WT + (size_t)(drow0 + n) * K + k0 + 8 * c) = (v4u){lo.x, lo.y, hi.x, hi.y}; }
    LDS_WAIT(); asm volatile("" ::: "memory");
}
__device__ __forceinline__ void transpose_item_fp8(const float* W, int K, int ldw, unsigned char* WT8, int kb, int n0, int drow0, LAS unsigned char* scr, int lane, float scale) {
    const int k0 = 64 * kb;
    const float* src = W + (size_t)k0 * ldw + n0 + lane;
    float v[64];
#pragma unroll
    for (int kk = 0; kk < 64; ++kk) v[kk] = src[(size_t)kk * ldw];
    LAS unsigned* row = (LAS unsigned*)(scr + lane * 68);
#pragma unroll
    for (int kk = 0; kk < 64; kk += 4) row[kk >> 2] = pg8::pk4_fp8(v[kk] * scale, v[kk + 1] * scale, v[kk + 2] * scale, v[kk + 3] * scale);
    LDS_WAIT(); asm volatile("" ::: "memory");
    const int c = lane & 3, r = lane >> 2;
#pragma unroll
    for (int i = 0; i < 4; ++i) { const int n = r + 16 * i; const LAS unsigned* p = (const LAS unsigned*)(scr + n * 68 + c * 16);
        *(GAS v4u*)(WT8 + (size_t)(drow0 + n) * K + k0 + 16 * c) = (v4u){p[0], p[1], p[2], p[3]}; }
    LDS_WAIT(); asm volatile("" ::: "memory");
}
__device__ __forceinline__ void strip_i8_wg(const float* W, int ldw, unsigned char* WT8, float* sw, int n0, int drow0, LAS unsigned char* lds, int wave, int lane) {
    constexpr int K = D;
    const float* src = W + (size_t)(128 * wave) * ldw + n0 + lane;
    float v[128]; float mx = 0.f;
#pragma unroll
    for (int kk = 0; kk < 128; ++kk) v[kk] = src[(size_t)kk * ldw];
#pragma unroll
    for (int kk = 0; kk < 128; ++kk) mx = __builtin_fmaxf(mx, __builtin_fabsf(v[kk]));
    LAS float* part = (LAS float*)lds;
    part[wave * 64 + lane] = mx;
    __syncthreads();
    float cm = part[lane];
#pragma unroll
    for (int w2 = 1; w2 < 8; ++w2) cm = __builtin_fmaxf(cm, part[w2 * 64 + lane]);
    cm = wave_max_nonneg(cm);
    if (wave == 0) sw[drow0 + lane] = cm * (1.0f / 127.0f);
    const float inv = cm > 0.f ? 127.0f / cm : 0.f;
    LAS unsigned char* scr = lds + 4096 + wave * 8192;
#pragma unroll
    for (int half = 0; half < 2; ++half) {
        LAS unsigned* row = (LAS unsigned*)(scr + lane * 68);
#pragma unroll
        for (int kk = 0; kk < 64; kk += 4) row[kk >> 2] = pk4_i8(v[64 * half + kk] * inv, v[64 * half + kk + 1] * inv, v[64 * half + kk + 2] * inv, v[64 * half + kk + 3] * inv);
        LDS_WAIT(); asm volatile("" ::: "memory");
        const int c = lane & 3, r = lane >> 2, k0 = 128 * wave + 64 * half;
#pragma unroll
        for (int i = 0; i < 4; ++i) { const int n = r + 16 * i; const LAS unsigned* p = (const LAS unsigned*)(scr + n * 68 + c * 16);
            *(GAS v4u*)(WT8 + (size_t)(drow0 + n) * K + k0 + 16 * c) = (v4u){p[0], p[1], p[2], p[3]}; }
        LDS_WAIT(); asm volatile("" ::: "memory");
    }
    __syncthreads();
}
__device__ __forceinline__ void prologue_strips(ArgP a, LAS unsigned char* lds, int wg, int G, int wave, int lane) {
    unsigned char* ws = a->ws;
    constexpr int NS_IN = 2 * 32, NS_GU = 9 * 2 * 56;
    for (int st = wg; st < NS_IN + NS_GU; st += G) {
        if (st < NS_IN) { const int l = st / 32, r = st % 32;
            strip_i8_wg(a->in[I_WIN] + (size_t)l * D * INCOLS, INCOLS, ws + WS_WIN + (size_t)l * NIN * D * 2, (float*)(ws + WS_SWIN) + l * NIN, 64 * r, 64 * r, lds, wave, lane); }
        else { const int q = st - NS_IN, blk = q / 112, r2 = q % 112, up = r2 / 56, r = r2 % 56;
            const float* w = (blk == 0) ? (up ? a->in[I_FU] : a->in[I_FG]) : ((up ? a->in[I_MU] : a->in[I_MG]) + (size_t)(blk - 1) * D * DFF);
            unsigned char* dst = (blk == 0) ? ws + WS_WDEN : ws + WS_WMOE + (size_t)(blk - 1) * WMOE_E;
            strip_i8_wg(w, DFF, dst, (float*)(ws + WS_SW) + (size_t)blk * (2 * DFF), 64 * r, 256 * ((64 * r) >> 7) + ((64 * r) & 127) + 128 * up, lds, wave, lane); }
    }
}
__device__ __forceinline__ int gu_row(int n0, int up) { return 256 * (n0 >> 7) + (n0 & 127) + 128 * up; }

__device__ __forceinline__ void prologue_transposes(ArgP a, LAS unsigned char* lds, int slotA, int slotB, int nslots, int wave, int lane) {
    LAS unsigned char* scr = lds + wave * 16384;
    unsigned char* ws = a->ws;
    constexpr int IT_WOUT = 16 * 16, IT_GLU = 8 * 8, IT_DN = 56 * 16;
    constexpr int NITEMS = 2 * IT_WOUT + 2 * IT_GLU + (1 + NE) * IT_DN;
    struct Desc { const float* src; unsigned char* dst; int ldw, K, k0, n0, fp8; };
    auto item_of = [&](int k) -> int { const int it = (slotB < 0) ? slotA + k * nslots : ((k & 1) ? slotB : slotA) + (k >> 1) * nslots; return it < NITEMS ? it : -1; };
    auto decode = [&](int it, Desc& d) {
        int r = it;
        if (r < 2 * IT_WOUT) { const int l = r / IT_WOUT; r %= IT_WOUT; d.src = a->in[I_WOUT] + (size_t)l * D * D; d.dst = ws + WS_WOUT + (size_t)l * D * D * 2; d.ldw = D; d.K = D; d.k0 = 64 * (r / 16); d.n0 = 64 * (r % 16); d.fp8 = 0; return; }
        r -= 2 * IT_WOUT;
        if (r < 2 * IT_GLU) { const int l = r / IT_GLU; r %= IT_GLU; d.src = a->in[I_WGLU] + (size_t)l * S5W * S5W; d.dst = ws + WS_WGLU + (size_t)l * S5W * S5W * 2; d.ldw = S5W; d.K = S5W; d.k0 = 64 * (r / 8); d.n0 = 64 * (r % 8); d.fp8 = 0; return; }
        r -= 2 * IT_GLU;
        const int blk = r / IT_DN; r %= IT_DN;
        d.src = (blk == 0) ? a->in[I_FD] : a->in[I_MD] + (size_t)(blk - 1) * DFF * D;
        d.dst = ((blk == 0) ? ws + WS_WDEN : ws + WS_WMOE + (size_t)(blk - 1) * WMOE_E) + WMOE_D;
        d.ldw = D; d.K = DFF; d.k0 = 64 * (r / 16); d.n0 = 64 * (r % 16); d.fp8 = 1; };
    auto load = [&](const Desc& d, float (&v)[64]) { const float* src = d.src + (size_t)d.k0 * d.ldw + d.n0 + lane;
#pragma unroll
        for (int kk = 0; kk < 64; ++kk) v[kk] = src[(size_t)kk * d.ldw]; };
    auto store = [&](const Desc& d, float (&v)[64]) {
        if (d.fp8) { LAS unsigned* row = (LAS unsigned*)(scr + lane * 68);
#pragma unroll
            for (int kk = 0; kk < 64; kk += 4) row[kk >> 2] = pg8::pk4_fp8(v[kk] * pg8::WD_SCALE, v[kk + 1] * pg8::WD_SCALE, v[kk + 2] * pg8::WD_SCALE, v[kk + 3] * pg8::WD_SCALE);
            LDS_WAIT(); asm volatile("" ::: "memory");
            const int c = lane & 3, r = lane >> 2;
#pragma unroll
            for (int i = 0; i < 4; ++i) { const int n = r + 16 * i; const LAS unsigned* pq = (const LAS unsigned*)(scr + n * 68 + c * 16);
                *(GAS v4u*)(d.dst + (size_t)(d.n0 + n) * d.K + d.k0 + 16 * c) = (v4u){pq[0], pq[1], pq[2], pq[3]}; }
            LDS_WAIT(); asm volatile("" ::: "memory"); }
        else { LAS unsigned* row = (LAS unsigned*)(scr + lane * (TP_RS * 2));
#pragma unroll
            for (int kk = 0; kk < 64; kk += 2) row[kk >> 1] = pk2(v[kk], v[kk + 1]);
            LDS_WAIT(); asm volatile("" ::: "memory");
            const int c = lane & 7, r = lane >> 3;
#pragma unroll
            for (int i = 0; i < 8; ++i) { const int n = r + 8 * i; const LAS v2u* pq = (const LAS v2u*)(scr + n * (TP_RS * 2) + c * 16); const v2u lo = pq[0], hi = pq[1];
                *(GAS v4u*)((bf16*)d.dst + (size_t)(d.n0 + n) * d.K + d.k0 + 8 * c) = (v4u){lo.x, lo.y, hi.x, hi.y}; }
            LDS_WAIT(); asm volatile("" ::: "memory"); } };
    int it = item_of(0); if (it < 0) return;
    Desc da, db; float va[64], vb[64];
    decode(it, da); load(da, va);
    for (int k = 1;; k += 2) {
        const int i1 = item_of(k);
        if (i1 >= 0) { decode(i1, db); load(db, vb); }
        store(da, va);
        if (i1 < 0) break;
        const int i2 = item_of(k + 1);
        if (i2 >= 0) { decode(i2, da); load(da, va); }
        store(db, vb);
        if (i2 < 0) break;
    }
}

__device__ __forceinline__ void prologue_comb(ArgP a, LAS unsigned char* lds, int wg, int tid) {
    if (wg >= 2 * GDK / 4) return;
    LAS float* part = (LAS float*)lds;
    const int c4 = tid >> 7, k0 = (tid & 127) * 8, col = wg * 4 + c4, l = col / GDK, n = col % GDK;
    const float* win = a->in[I_WIN] + (size_t)l * D * INCOLS + 2048; const float* wup = a->in[I_WAUP] + (size_t)l * GRANK * GDK + n;
    float o[8]; float mx = 0.f;
#pragma unroll
    for (int j = 0; j < 8; ++j) { float sacc = 0.f;
#pragma unroll
        for (int rr = 0; rr < GRANK; ++rr) sacc += win[(size_t)(k0 + j) * INCOLS + rr] * wup[rr * GDK];
        o[j] = sacc; mx = __builtin_fmaxf(mx, __builtin_fabsf(sacc)); }
    { const float wm = wave_max_nonneg(mx); if ((tid & 63) == 0) part[tid >> 6] = wm; }
    __syncthreads();
    const float cm = __builtin_fmaxf(part[2 * c4], part[2 * c4 + 1]), inv = cm > 0.f ? 127.0f / cm : 0.f;
    if ((tid & 127) == 0) ((float*)(a->ws + WS_SWIN))[l * NIN + 2048 + n] = cm * (1.0f / 127.0f);
    v2u w; w.x = pk4_i8(o[0] * inv, o[1] * inv, o[2] * inv, o[3] * inv); w.y = pk4_i8(o[4] * inv, o[5] * inv, o[6] * inv, o[7] * inv);
    *(v2u*)(a->ws + WS_WIN + (size_t)l * NIN * D * 2 + (size_t)(2048 + n) * D + k0) = w;
    __syncthreads();
}

__device__ __forceinline__ void prologue_mod(ArgP a, LAS unsigned char* lds, int wg, int G, int tid) {
    LAS float* cact = (LAS float*)lds;
    LAS float* part = (LAS float*)(lds + 16 * 1024 * 4);
    const float* c = a->in[I_C];
    constexpr int NCB = NMOD * D / 64;
    constexpr int NITEM = 2 * 2 * NCB;
    if (wg < 64) return;
    for (int it = wg - 64; it < NITEM; it += G - 64) {
        const int l = it / (2 * NCB), bh = (it / NCB) & 1, j0 = (it % NCB) * 64;
        for (int i = tid; i < 16 * D; i += 512) { const int b = i >> 10, k = i & 1023; cact[k * 16 + b] = siluf_(c[bh * 16 * D + i]); }
        __syncthreads();
        const int col = tid & 63, ks = tid >> 6;
        const float* w = a->in[I_MODW] + (size_t)l * D * NMOD * D + j0 + col + (size_t)(ks * 128) * NMOD * D;
        f32x4 accv[4];
#pragma unroll
        for (int q = 0; q < 4; ++q) accv[q] = (f32x4){0.f, 0.f, 0.f, 0.f};
        for (int k0 = 0; k0 < 128; k0 += 32) { float wv[32];
#pragma unroll
            for (int kk = 0; kk < 32; ++kk) wv[kk] = w[(size_t)(k0 + kk) * NMOD * D];
#pragma unroll
            for (int kk = 0; kk < 32; ++kk) { const LAS f32x4* cp = (const LAS f32x4*)(cact + (ks * 128 + k0 + kk) * 16);
#pragma unroll
                for (int q = 0; q < 4; ++q) accv[q] += cp[q] * wv[kk]; } }
#pragma unroll
        for (int q = 0; q < 4; ++q) *(LAS f32x4*)(part + (ks * 64 + col) * 16 + 4 * q) = accv[q];
        __syncthreads();
        for (int o = tid; o < 64 * 16; o += 512) { const int cc = o & 63, b = o >> 6; float s = a->in[I_MODB][l * NMOD * D + j0 + cc];
#pragma unroll
            for (int q = 0; q < 8; ++q) s += part[(q * 64 + cc) * 16 + b];
            ((float*)(a->ws + WS_MOD))[((size_t)l * BATCH + bh * 16 + b) * NMOD * D + j0 + cc] = s; }
        __syncthreads();
    }
}
__device__ __forceinline__ void prologue_s5(ArgP a, LAS unsigned char* lds, int lg, int tid) {
    const int l = lg >> 5, g = lg & 31;
    LAS float* pwr = (LAS float*)lds;
    LAS float* pwi = pwr + 64 * 33;
    LAS float* bbr = pwi + 64 * 33;
    LAS float* bbi = bbr + 64 * 16;
    LAS float* ccr = bbi + 64 * 16;
    LAS float* cci = ccr + 16 * 64;
    LAS float* kt = cci + 16 * 64;
    LAS double* f1 = (LAS double*)(kt + 32 * 256);
    const float* lre = a->in[I_LRE] + (size_t)(l * S5G + g) * S5P; const float* lim = a->in[I_LIM] + (size_t)(l * S5G + g) * S5P;
    const double dt = exp((double)a->in[I_LDT][l * S5G + g]);
    const float* bre = a->in[I_BRE] + (size_t)(l * S5G + g) * S5P * S5H; const float* bim = a->in[I_BIM] + (size_t)(l * S5G + g) * S5P * S5H;
    const float* cre = a->in[I_CRE] + (size_t)(l * S5G + g) * S5H * S5P; const float* cim = a->in[I_CIM] + (size_t)(l * S5G + g) * S5H * S5P;
    for (int i = tid; i < 64 * 33; i += 512) { const int p = i / 33, tau = i % 33; const double ar = (double)lre[p] * dt * tau, ai = (double)lim[p] * dt * tau, e = exp(ar), cr = e * cos(ai), ci = e * sin(ai);
        pwr[i] = (float)cr; pwi[i] = (float)ci;
        if (tau == 1) { const double lr = lre[p], li = lim[p], nr = cr - 1.0, den = lr * lr + li * li; f1[2 * p] = (nr * lr + ci * li) / den; f1[2 * p + 1] = (ci * lr - nr * li) / den; } }
    for (int i = tid; i < 16 * 64; i += 512) { ccr[i] = cre[i]; cci[i] = cim[i]; }
    __syncthreads();
    for (int i = tid; i < 64 * 16; i += 512) { const int p = i >> 4; const double fr_ = f1[2 * p], fi_ = f1[2 * p + 1], br = bre[i], bi = bim[i]; bbr[i] = (float)(fr_ * br - fi_ * bi); bbi[i] = (float)(fr_ * bi + fi_ * br); }
    if (tid < 64) { float* lt = (float*)(a->ws + WS_LAMT) + ((size_t)(l * S5G + g) * S5P + tid) * 2; lt[0] = pwr[tid * 33 + 32]; lt[1] = pwi[tid * 33 + 32]; }
    __syncthreads();
    { const int tau = tid >> 4, hp = tid & 15;
      f32x4 acc4[4];
#pragma unroll
      for (int q = 0; q < 4; ++q) acc4[q] = (f32x4){0.f, 0.f, 0.f, 0.f};
      for (int p = 0; p < 64; ++p) { const float cr = ccr[hp * 64 + p], ci = cci[hp * 64 + p], wr_ = pwr[p * 33 + tau], wi_ = pwi[p * 33 + tau];
          const float tr = cr * wr_ - ci * wi_, ti = cr * wi_ + ci * wr_;
#pragma unroll
          for (int q = 0; q < 4; ++q) acc4[q] += *(const LAS f32x4*)(bbr + p * 16 + 4 * q) * tr - *(const LAS f32x4*)(bbi + p * 16 + 4 * q) * ti; }
#pragma unroll
      for (int q = 0; q < 4; ++q) *(LAS f32x4*)(kt + (tau * 16 + hp) * 16 + 4 * q) = acc4[q]; }
    __syncthreads();
    bf16* toep = (bf16*)(a->ws + WS_TOEP) + (size_t)(l * S5G + g) * S5KU * S5LDA;
    for (int i = tid; i < S5KU * (S5LDA / 8); i += 512) { const int row = i / (S5LDA / 8), c0 = (i % (S5LDA / 8)) * 8, ii = row >> 4, hp = row & 15; float o[8];
#pragma unroll
        for (int j = 0; j < 8; ++j) { const int col = c0 + j; float v;
            if (col < S5KU) { const int jj = col >> 4, h = col & 15; v = (jj <= ii) ? kt[((ii - jj) * 16 + hp) * 16 + h] : 0.f; }
            else { const int p = (col - S5KU) & 63; const float cr = ccr[hp * 64 + p], ci = cci[hp * 64 + p], wr_ = pwr[p * 33 + ii + 1], wi_ = pwi[p * 33 + ii + 1];
                v = (col < S5KU + 64) ? (cr * wr_ - ci * wi_) : -(cr * wi_ + ci * wr_); }
            o[j] = v; }
        v4u w; w.x = pk2(o[0], o[1]); w.y = pk2(o[2], o[3]); w.z = pk2(o[4], o[5]); w.w = pk2(o[6], o[7]);
        *(v4u*)(toep + (size_t)row * S5LDA + c0) = w; }
    bf16* ctrl = (bf16*)(a->ws + WS_CTRL) + (size_t)(l * S5G + g) * 256 * S5KU;
    for (int i = tid; i < 256 * (S5KU / 8); i += 512) { const int row = i / (S5KU / 8), c0 = (i % (S5KU / 8)) * 8; float o[8];
#pragma unroll
        for (int j = 0; j < 8; ++j) { const int col = c0 + j, jj = col >> 4, h = col & 15; float v = 0.f;
            if (row < 128) { const int p = row & 63; const float wr_ = pwr[p * 33 + 31 - jj], wi_ = pwi[p * 33 + 31 - jj], br = bbr[p * 16 + h], bi = bbi[p * 16 + h];
                v = (row < 64) ? (wr_ * br - wi_ * bi) : (wr_ * bi + wi_ * br); }
            o[j] = v; }
        v4u w; w.x = pk2(o[0], o[1]); w.y = pk2(o[2], o[3]); w.z = pk2(o[4], o[5]); w.w = pk2(o[6], o[7]);
        *(v4u*)(ctrl + (size_t)row * S5KU + c0) = w; }
    __syncthreads();
}

__device__ __forceinline__ f32x4 carrier4(unsigned qd, unsigned rd, float s, float s254, float c0) {
    const unsigned qu = qd ^ 0x80808080u;
    f32x4 h;
    h.x = __builtin_fmaf((float)((rd >> 0) & 255u), s254, __builtin_fmaf((float)((qu >> 0) & 255u), s, c0));
    h.y = __builtin_fmaf((float)((rd >> 8) & 255u), s254, __builtin_fmaf((float)((qu >> 8) & 255u), s, c0));
    h.z = __builtin_fmaf((float)((rd >> 16) & 255u), s254, __builtin_fmaf((float)((qu >> 16) & 255u), s, c0));
    h.w = __builtin_fmaf((float)((rd >> 24) & 255u), s254, __builtin_fmaf((float)((qu >> 24) & 255u), s, c0));
    return h; }
__device__ __forceinline__ void carrier_q4(f32x4 hq  , unsigned& qd, unsigned& rd) {
    const f32x4 qf = {__builtin_rintf(hq.x), __builtin_rintf(hq.y), __builtin_rintf(hq.z), __builtin_rintf(hq.w)};
    qd = ((unsigned)(int)qf.x & 0xffu) | (((unsigned)(int)qf.y & 0xffu) << 8) | (((unsigned)(int)qf.z & 0xffu) << 16) | ((unsigned)(int)qf.w << 24);
    const f32x4 rr = (hq - qf) * 254.0f + 128.5f;
    unsigned r = 0u;
    r = __builtin_amdgcn_cvt_pk_u8_f32(rr.x, 0, r); r = __builtin_amdgcn_cvt_pk_u8_f32(rr.y, 1, r); r = __builtin_amdgcn_cvt_pk_u8_f32(rr.z, 2, r); r = __builtin_amdgcn_cvt_pk_u8_f32(rr.w, 3, r);
    rd = r; }
#ifndef ROW_INTERLEAVE
#define ROW_INTERLEAVE 1
#endif
#if ROW_INTERLEAVE
#define ROW_OF(rr_) (wg * 256 + (rr_) * 8 + wave)
#else
#define ROW_OF(rr_) (wg * 256 + wave * 32 + (rr_))
#endif
#define ROW0_LANDED4(v_) asm volatile("" :: "v"((v_)[0]), "v"((v_)[1]), "v"((v_)[2]), "v"((v_)[3]))
#define ROW0_LANDED2(v_) asm volatile("" :: "v"((v_)[0]), "v"((v_)[1]))
__device__ __forceinline__ void hmod_rows(const float* x, const float* mod  , int sh_off, int sc_off, bf16* hmod, unsigned char* ws, int wg, int wave, int lane) {
    const float* mb = mod + (size_t)(wg >> 3) * NMOD * D;
    f32x4 pSc[4], pSh[4];
#pragma unroll
    for (int jj = 0; jj < 4; ++jj) { const int o = 8 * lane + 512 * (jj >> 1) + 4 * (jj & 1); pSc[jj] = *(const f32x4*)(mb + sc_off + o) + 1.0f; pSh[jj] = *(const f32x4*)(mb + sh_off + o); }
    f32x4 ax[4], bx[4];
#define HM_LOAD(X_, rr_) do { const GAS f32x4* xr_ = (const GAS f32x4*)(x + (size_t)ROW_OF(rr_) * D) + 2 * lane; _Pragma("unroll") for (int jj = 0; jj < 4; ++jj) X_[jj] = xr_[128 * (jj >> 1) + (jj & 1)]; } while (0)
    HM_LOAD(ax, 0); HM_LOAD(bx, 1);
    ROW0_LANDED4(pSc); ROW0_LANDED4(pSh); ROW0_LANDED4(ax); ROW0_LANDED4(bx);
    float sa_keep = 0.f;
    auto one_row = [&](f32x4 (&X)[4], const int rr, const bool reload) __attribute__((always_inline)) { const int m = ROW_OF(rr);
        f32x4 hv[4]; float hmax = 0.f;
#pragma unroll
        for (int jj = 0; jj < 4; ++jj) hv[jj] = X[jj] * pSc[jj] + pSh[jj];
        if (reload) HM_LOAD(X, rr + 2);
#pragma unroll
        for (int jj = 0; jj < 4; ++jj) hmax = __builtin_fmaxf(hmax, __builtin_fmaxf(__builtin_fmaxf(__builtin_fabsf(hv[jj].x), __builtin_fabsf(hv[jj].y)), __builtin_fmaxf(__builtin_fabsf(hv[jj].z), __builtin_fabsf(hv[jj].w))));
        const float rmax = wave_max_nonneg(hmax), qs = rmax > 0.f ? 127.0f / rmax : 0.f;
        GAS v2u* h8 = (GAS v2u*)(ws + WS_H8 + (size_t)m * D) + lane;
#pragma unroll
        for (int j = 0; j < 2; ++j) { v2u w; w.x = pk4_i8(hv[2 * j].x * qs, hv[2 * j].y * qs, hv[2 * j].z * qs, hv[2 * j].w * qs); w.y = pk4_i8(hv[2 * j + 1].x * qs, hv[2 * j + 1].y * qs, hv[2 * j + 1].z * qs, hv[2 * j + 1].w * qs); h8[64 * j] = w; }
        sa_keep = (lane == rr) ? rmax * (1.0f / 127.0f) : sa_keep; };
    for (int rr = 0; rr < 30; rr += 2) { one_row(ax, rr, true); one_row(bx, rr + 1, true); }
    one_row(ax, 30, false); one_row(bx, 31, false);
#undef HM_LOAD
    if (lane < 32) ((float*)(ws + WS_SA))[ROW_OF(lane)] = sa_keep;
}

constexpr int GL_RS = 72;
constexpr int G2_QT = 0, G2_KT = 64 * GL_RS * 2, G2_KDT = 2 * 64 * GL_RS * 2, G2_VT = 3 * 64 * GL_RS * 2, G2_SET = (3 * 64 + 128) * GL_RS * 2;
constexpr int G2_ST = 2 * G2_SET, G2_P = G2_ST + 128 * GL_RS * 2, G2_DV = G2_P + 4 * 16 * GL_RS * 2, G2_PART = G2_DV + 2 * 64 * 4, G2_END = G2_PART + 64 * 4 * 4;
static_assert(G2_END <= RING_BYTES, "gla lds");
__device__ __forceinline__ bf16x8 lds_frag(const LAS unsigned char* base, int row, int kq) { return *(const LAS bf16x8*)(base + (row * GL_RS + kq * 8) * 2); }
#define GLA_BAR() do { asm volatile("s_waitcnt lgkmcnt(0)" ::: "memory"); __builtin_amdgcn_s_barrier(); asm volatile("" ::: "memory"); } while (0)
__device__ __forceinline__ void gla_phase(ArgP a, int l, LAS unsigned char* lds, int wg, int tid) {
    if (wg >= BATCH * GNH) return;
    constexpr int NC = SEQ / GCH;
    const int b = wg >> 2, h = wg & 3, lane = tid & 63, w = __builtin_amdgcn_readfirstlane(tid >> 6), fr = lane & 15, fq = lane >> 4;
    for (int i = tid; i < 128 * GL_RS / 2; i += 512) ((LAS unsigned*)(lds + G2_ST))[i] = 0u;
    if (w < 4) {
        const int p = w;
        const bf16* lag = (const bf16*)(a->ws + WS_LA) + (size_t)b * SEQ * GDK + h * GHK + 16 * p;
        const bf16* qg = (const bf16*)(a->ws + WS_Q) + (size_t)b * SEQ * GDK + h * GHK + 16 * p;
        const bf16* kg = (const bf16*)(a->ws + WS_K) + (size_t)b * SEQ * GDK + h * GHK + 16 * p;
        const bf16* vg = (const bf16*)(a->ws + WS_V) + (size_t)b * SEQ * GW + h * GHV + 32 * p;
        v4u rla[2]; v4u rq[2], rk[2], rv[4];
#define GLP_LOAD(cc) do { const size_t ro = (size_t)((cc) * GCH + lane) * GDK; const size_t rov = (size_t)((cc) * GCH + lane) * GW; \
            rla[0] = *(const v4u*)(lag + ro); rla[1] = *(const v4u*)(lag + ro + 8); \
            rq[0] = *(const v4u*)(qg + ro); rq[1] = *(const v4u*)(qg + ro + 8); rk[0] = *(const v4u*)(kg + ro); rk[1] = *(const v4u*)(kg + ro + 8); \
            _Pragma("unroll") for (int j = 0; j < 4; ++j) rv[j] = *(const v4u*)(vg + rov + 8 * j); } while (0)
#define GLP_PREP(setoff) do { LAS unsigned char* S_ = lds + (setoff); \
            float bb[16]; \
            _Pragma("unroll") for (int j = 0; j < 16; ++j) { const unsigned lw_ = rla[j >> 3][(j >> 1) & 3]; float x = (j & 1) ? bfhi(lw_) : bflo(lw_); \
                x += DPP_F(x, 0x111, 0xF); x += DPP_F(x, 0x112, 0xF); x += DPP_F(x, 0x114, 0xF); x += DPP_F(x, 0x118, 0xF);     \
                x += DPP_F(x, 0x142, 0xA); x += DPP_F(x, 0x143, 0xC); bb[j] = x; }                                              \
            const unsigned qw[8] = {rq[0].x, rq[0].y, rq[0].z, rq[0].w, rq[1].x, rq[1].y, rq[1].z, rq[1].w}; \
            const unsigned kw[8] = {rk[0].x, rk[0].y, rk[0].z, rk[0].w, rk[1].x, rk[1].y, rk[1].z, rk[1].w}; \
            unsigned qo[8], ko[8]; float dl[16]; \
            _Pragma("unroll") for (int j2 = 0; j2 < 8; ++j2) { \
                const float bl0 = __builtin_bit_cast(float, __builtin_amdgcn_readlane(__builtin_bit_cast(int, bb[2 * j2]), 63)), bl1 = __builtin_bit_cast(float, __builtin_amdgcn_readlane(__builtin_bit_cast(int, bb[2 * j2 + 1]), 63)); \
                const float E0 = __expf(bl0), E1 = __expf(bl1); dl[2 * j2] = E0; dl[2 * j2 + 1] = E1; \
                const float e0 = __expf(bb[2 * j2]), e1 = __expf(bb[2 * j2 + 1]), r0 = frcp(e0), r1 = frcp(e1); \
                const float q0 = bflo(qw[j2]), q1 = bfhi(qw[j2]), k0 = bflo(kw[j2]), k1 = bfhi(kw[j2]); \
                qo[j2] = pk2(q0 * 0.125f * e0, q1 * 0.125f * e1); const float kt0 = k0 * r0, kt1 = k1 * r1; ko[j2] = pk2(kt0, kt1); \
                ((LAS bf16*)(S_ + G2_KDT))[(16 * p + 2 * j2) * GL_RS + lane] = (bf16)f2bf(kt0 * E0); ((LAS bf16*)(S_ + G2_KDT))[(16 * p + 2 * j2 + 1) * GL_RS + lane] = (bf16)f2bf(kt1 * E1); } \
            *(LAS v4u*)(S_ + G2_QT + (lane * GL_RS + 16 * p) * 2) = (v4u){qo[0], qo[1], qo[2], qo[3]}; *(LAS v4u*)(S_ + G2_QT + (lane * GL_RS + 16 * p + 8) * 2) = (v4u){qo[4], qo[5], qo[6], qo[7]}; \
            *(LAS v4u*)(S_ + G2_KT + (lane * GL_RS + 16 * p) * 2) = (v4u){ko[0], ko[1], ko[2], ko[3]}; *(LAS v4u*)(S_ + G2_KT + (lane * GL_RS + 16 * p + 8) * 2) = (v4u){ko[4], ko[5], ko[6], ko[7]}; \
            if (lane == 0) { LAS float* dv_ = (LAS float*)(lds + G2_DV) + ((setoff) ? 64 : 0) + 16 * p; \
                _Pragma("unroll") for (int j = 0; j < 4; ++j) *(LAS f32x4*)(dv_ + 4 * j) = (f32x4){dl[4 * j], dl[4 * j + 1], dl[4 * j + 2], dl[4 * j + 3]}; } \
            const unsigned vw[16] = {rv[0].x, rv[0].y, rv[0].z, rv[0].w, rv[1].x, rv[1].y, rv[1].z, rv[1].w, rv[2].x, rv[2].y, rv[2].z, rv[2].w, rv[3].x, rv[3].y, rv[3].z, rv[3].w}; \
            _Pragma("unroll") for (int j = 0; j < 16; ++j) { ((LAS bf16*)(S_ + G2_VT))[(32 * p + 2 * j) * GL_RS + lane] = (bf16)(vw[j] & 0xffffu); ((LAS bf16*)(S_ + G2_VT))[(32 * p + 2 * j + 1) * GL_RS + lane] = (bf16)(vw[j] >> 16); } \
        } while (0)
        GLP_LOAD(0);
        GLP_PREP(0);
        GLP_LOAD(1);
        GLA_BAR();
        for (int c = 0; c < NC; ++c) {
            if (c + 1 < NC) for (int pr_ = 0; pr_ < GLA_PROD_REPS; ++pr_) { if ((c + 1) & 1) GLP_PREP(G2_SET); else GLP_PREP(0); }
            if (c + 2 < NC) GLP_LOAD(c + 2);
            GLA_BAR();
            GLA_BAR();
        }
#undef GLP_LOAD
#undef GLP_PREP
    } else {
        const int cw = w - 4;
        const bf16* gg = (const bf16*)(a->ws + WS_GO) + (size_t)b * SEQ * GW + h * GHV + 32 * cw;
        bf16* yo = (bf16*)(a->ws + WS_YCAT) + (size_t)b * SEQ * D + S5W + h * GHV + 32 * cw;
        const float* gain = a->in[I_GAIN] + l * GW + h * GHV + 32 * cw;
        float gn[2][4];
#pragma unroll
        for (int vt = 0; vt < 2; ++vt)
#pragma unroll
            for (int r = 0; r < 4; ++r) gn[vt][r] = gain[16 * vt + 4 * fq + r];
        LAS unsigned char* STp = lds + G2_ST; LAS unsigned char* Pp = lds + G2_P + cw * (16 * GL_RS * 2); LAS float* PART = (LAS float*)(lds + G2_PART);
        f32x4 accS[4][2];
#pragma unroll
        for (int kt = 0; kt < 4; ++kt) { accS[kt][0] = (f32x4){0.f, 0.f, 0.f, 0.f}; accS[kt][1] = (f32x4){0.f, 0.f, 0.f, 0.f}; }
        v2u ng[4][2];
#define GLC_LOADG(cc) do { _Pragma("unroll") for (int it = 0; it < 4; ++it) _Pragma("unroll") for (int vt = 0; vt < 2; ++vt) \
            ng[it][vt] = *(const v2u*)(gg + (size_t)((cc) * GCH + 16 * it + fr) * GW + 16 * vt + 4 * fq); } while (0)
        GLC_LOADG(0);
        GLA_BAR();
        for (int c = 0; c < NC; ++c) {
            const int t0 = c * GCH;
            const LAS unsigned char* S_ = lds + ((c & 1) ? G2_SET : 0);
            v2u gv[4][2];
#pragma unroll
            for (int it = 0; it < 4; ++it) { gv[it][0] = ng[it][0]; gv[it][1] = ng[it][1]; }
            if (c + 1 < NC) GLC_LOADG(c + 1);
            bf16x8 sa[2][2], va[2][2], ka[4][2];
#pragma unroll
            for (int vt = 0; vt < 2; ++vt) { sa[vt][0] = lds_frag(STp, 32 * cw + 16 * vt + fr, fq); sa[vt][1] = lds_frag(STp, 32 * cw + 16 * vt + fr, 4 + fq);
                va[vt][0] = lds_frag(S_ + G2_VT, 32 * cw + 16 * vt + fr, fq); va[vt][1] = lds_frag(S_ + G2_VT, 32 * cw + 16 * vt + fr, 4 + fq); }
#pragma unroll
            for (int jt = 0; jt < 4; ++jt) { ka[jt][0] = lds_frag(S_ + G2_KT, 16 * jt + fr, fq); ka[jt][1] = lds_frag(S_ + G2_KT, 16 * jt + fr, 4 + fq); }
            f32x4 o[4][2]; float ssq[4];
#pragma unroll
            for (int it = 0; it < 4; ++it) {
                const bf16x8 qa0 = lds_frag(S_ + G2_QT, 16 * it + fr, fq), qa1 = lds_frag(S_ + G2_QT, 16 * it + fr, 4 + fq);
#pragma unroll
                for (int jt = 0; jt < 4; ++jt) { if (jt > (it | 1)) continue;
                    v2u pw = (v2u){0u, 0u};
                    if (jt <= it) { f32x4 sc = (f32x4){0.f, 0.f, 0.f, 0.f};
                        sc = __builtin_amdgcn_mfma_f32_16x16x32_bf16(ka[jt][0], qa0, sc, 0, 0, 0); sc = __builtin_amdgcn_mfma_f32_16x16x32_bf16(ka[jt][1], qa1, sc, 0, 0, 0);
                        if (jt == it) { const int d0 = 4 * fq - fr;
                            sc[0] = (d0 + 0 <= 0) ? sc[0] : 0.f; sc[1] = (d0 + 1 <= 0) ? sc[1] : 0.f; sc[2] = (d0 + 2 <= 0) ? sc[2] : 0.f; sc[3] = (d0 + 3 <= 0) ? sc[3] : 0.f; }
                        pw.x = pk2(sc[0], sc[1]); pw.y = pk2(sc[2], sc[3]); }
                    *(LAS v2u*)(Pp + (fr * GL_RS + 16 * jt + 4 * fq) * 2) = pw; }
                asm volatile("s_waitcnt lgkmcnt(0)" ::: "memory");
                const bf16x8 pa0 = lds_frag(Pp, fr, fq), pa1 = lds_frag(Pp, fr, 4 + fq);
                float ss = 0.f;
#pragma unroll
                for (int vt = 0; vt < 2; ++vt) { f32x4 acc = (f32x4){0.f, 0.f, 0.f, 0.f};
                    acc = __builtin_amdgcn_mfma_f32_16x16x32_bf16(sa[vt][0], qa0, acc, 0, 0, 0); acc = __builtin_amdgcn_mfma_f32_16x16x32_bf16(sa[vt][1], qa1, acc, 0, 0, 0);
                    acc = __builtin_amdgcn_mfma_f32_16x16x32_bf16(va[vt][0], pa0, acc, 0, 0, 0); if (it >= 2) acc = __builtin_amdgcn_mfma_f32_16x16x32_bf16(va[vt][1], pa1, acc, 0, 0, 0);
                    o[it][vt] = acc; ss += (acc[0] * acc[0] + acc[1] * acc[1]) + (acc[2] * acc[2] + acc[3] * acc[3]); }
                asm volatile("" ::: "memory");
                ssq[it] = ss;
            }
#pragma unroll
            for (int it = 0; it < 4; ++it) { float ss = ssq[it]; ss += __shfl_xor(ss, 16); ss += __shfl_xor(ss, 32); if (fq == 0) PART[(16 * it + fr) * 4 + cw] = ss; }
            { const LAS float* DVp = (const LAS float*)(lds + G2_DV) + ((c & 1) ? 64 : 0);
#pragma unroll
              for (int kt = 0; kt < 4; ++kt) { const f32x4 dv = *(const LAS f32x4*)(DVp + 16 * kt + 4 * fq);
                  const bf16x8 kd0 = lds_frag(S_ + G2_KDT, 16 * kt + fr, fq), kd1 = lds_frag(S_ + G2_KDT, 16 * kt + fr, 4 + fq);
#pragma unroll
                  for (int vt = 0; vt < 2; ++vt) { f32x4 sv = accS[kt][vt] * dv;
                      sv = __builtin_amdgcn_mfma_f32_16x16x32_bf16(kd0, va[vt][0], sv, 0, 0, 0); sv = __builtin_amdgcn_mfma_f32_16x16x32_bf16(kd1, va[vt][1], sv, 0, 0, 0);
                      accS[kt][vt] = sv;
                      v2u sw; sw.x = pk2(sv[0], sv[1]); sw.y = pk2(sv[2], sv[3]); *(LAS v2u*)(STp + ((32 * cw + 16 * vt + fr) * GL_RS + 16 * kt + 4 * fq) * 2) = sw; } } }
            GLA_BAR();
#pragma unroll
            for (int it = 0; it < 4; ++it) { const int i = 16 * it + fr; const f32x4 pp = *(const LAS f32x4*)(PART + i * 4);
                const float rs = frsq(((pp[0] + pp[1]) + (pp[2] + pp[3])) * (1.0f / 128.0f) + RMS_EPS);
#pragma unroll
                for (int vt = 0; vt < 2; ++vt) { const float g0 = bflo(gv[it][vt].x), g1 = bfhi(gv[it][vt].x), g2 = bflo(gv[it][vt].y), g3 = bfhi(gv[it][vt].y);
                    v2u ow; ow.x = pk2(o[it][vt][0] * rs * gn[vt][0] * siluf_(g0), o[it][vt][1] * rs * gn[vt][1] * siluf_(g1)); ow.y = pk2(o[it][vt][2] * rs * gn[vt][2] * siluf_(g2), o[it][vt][3] * rs * gn[vt][3] * siluf_(g3));
                    *(v2u*)(yo + (size_t)(t0 + i) * D + 16 * vt + 4 * fq) = ow; } }
            GLA_BAR();
        }
#undef GLC_LOADG
    }
    __syncthreads();
}
#undef GLA_BAR

struct RowVals { f32x4 v[4]; };
__device__ __forceinline__ void ln_normalise(RowVals& t, const float* g, const float* bta, int lane) {
    float s = 0.f;
#pragma unroll
    for (int j = 0; j < 4; ++j) s += (t.v[j].x + t.v[j].y) + (t.v[j].z + t.v[j].w);
    const float mean = wave_sum(s) * (1.f / D); float s2 = 0.f;
#pragma unroll
    for (int j = 0; j < 4; ++j) { t.v[j] = t.v[j] - mean; s2 += (t.v[j].x * t.v[j].x + t.v[j].y * t.v[j].y) + (t.v[j].z * t.v[j].z + t.v[j].w * t.v[j].w); }
    const float rstd = frsq(wave_sum(s2) * (1.f / D) + LN_EPS);
#pragma unroll
    for (int j = 0; j < 4; ++j) { const f32x4 gg = *(const f32x4*)(g + 4 * lane + 256 * j), bb = *(const f32x4*)(bta + 4 * lane + 256 * j); t.v[j] = t.v[j] * rstd * gg + bb; }
}
__device__ __forceinline__ void ln_mix_phase(ArgP a, int l, LAS unsigned char* lds, int wg, int tid) {
    const int lane = tid & 63, wave = __builtin_amdgcn_readfirstlane(tid >> 6);
    const bool moe = (l & 1) != 0;
    const float* xin = a->in[I_X];
    const float* mb = (const float*)(a->ws + WS_MOD) + ((size_t)l * BATCH + (wg >> 3)) * NMOD * D;
    unsigned char* h8p = a->ws + WS_H8; unsigned char* r8p = a->ws + WS_R8; float* sap = (float*)(a->ws + WS_SA); const bf16* yp = (const bf16*)a->out;
    LAS float* RW = (LAS float*)lds;
    LAS int* E0 = (LAS int*)(lds + 32768); LAS int* E1 = E0 + 256; LAS int* LP = E1 + 256;
    LAS float* W0 = (LAS float*)(LP + 512); LAS float* W1 = W0 + 256;
    if (moe) { const float* rw = a->in[I_RW] + (size_t)(l >> 1) * D * NE; for (int i = tid; i < D * NE; i += 512) RW[(i & 7) * D + (i >> 3)] = rw[i]; __syncthreads(); }
    f32x4 pGt[4], pG2[4], pB2[4];
    LAS f32x4* PR = (LAS f32x4*)(lds + 40960);
#pragma unroll
    for (int jj = 0; jj < 4; ++jj) { const int o = 8 * lane + 512 * (jj >> 1) + 4 * (jj & 1);
        const f32x4 gt = *(const f32x4*)(mb + 2 * D + o), shf = *(const f32x4*)(mb + 3 * D + o), scf = *(const f32x4*)(mb + 4 * D + o);
        const f32x4 g = *(const f32x4*)(a->in[I_LNMG] + l * D + o), bb = *(const f32x4*)(a->in[I_LNMB] + l * D + o);
        pGt[jj] = gt + 1.0f; pG2[jj] = g * (scf + 1.0f); pB2[jj] = bb * (scf + 1.0f) + shf;
        if (l != 0 && wave == 0) { const f32x4 scm = *(const f32x4*)(mb + 1 * D + o);
            PR[lane + 64 * jj] = (f32x4){frcp(1.f + scm.x), frcp(1.f + scm.y), frcp(1.f + scm.z), frcp(1.f + scm.w)}; PR[256 + lane + 64 * jj] = *(const f32x4*)(mb + 0 * D + o); } }
    __syncthreads();
    f32x4 ax[4], bx[4]; v4u ah[2], bh[2], ay[2], by[2];
    float sa_in = 0.f; if (l != 0 && lane < 32) sa_in = sap[ROW_OF(lane)];
#define LNM_LOAD(X_, H_, Y_, rr_) do { const int Rn = ROW_OF(rr_); const GAS v4u* yr_ = (const GAS v4u*)(yp + (size_t)Rn * D) + lane; \
        if (l == 0) { const GAS f32x4* xr_ = (const GAS f32x4*)(xin + (size_t)Rn * D) + 2 * lane; _Pragma("unroll") for (int jj = 0; jj < 4; ++jj) X_[jj] = xr_[128 * (jj >> 1) + (jj & 1)]; } \
        else { const GAS v2u* hq_ = (const GAS v2u*)(h8p + (size_t)Rn * D) + lane; const GAS v2u* hr_ = (const GAS v2u*)(r8p + (size_t)Rn * D) + lane; \
            _Pragma("unroll") for (int j = 0; j < 2; ++j) { const v2u q_ = hq_[64 * j], r_ = hr_[64 * j]; H_[j] = (v4u){q_.x, q_.y, r_.x, r_.y}; } } \
        _Pragma("unroll") for (int j = 0; j < 2; ++j) Y_[j] = yr_[64 * j]; } while (0)
    LNM_LOAD(ax, ah, ay, 0); LNM_LOAD(bx, bh, by, 1);
    ROW0_LANDED4(pGt); ROW0_LANDED4(pG2); ROW0_LANDED4(pB2);
    if (l == 0) { ROW0_LANDED4(ax); ROW0_LANDED4(bx); } else { ROW0_LANDED2(ah); ROW0_LANDED2(bh); }
    ROW0_LANDED2(ay); ROW0_LANDED2(by); asm volatile("" :: "v"(sa_in));
    float sa_keep = 0.f;
    auto one_row = [&](f32x4 (&X)[4], v4u (&H)[2], v4u (&Y)[2], const int rr, const bool reload) __attribute__((always_inline)) {
        const int R = ROW_OF(rr), rl = R & 255;
        f32x4 tv[4]; float s1 = 0.f;
        const float si = (l != 0) ? __shfl(sa_in, rr) : 0.f, si254 = si * (1.0f / 254.0f), sic = -128.0f * si - 128.0f * si254;
#pragma unroll
        for (int j = 0; j < 2; ++j) { f32x4 c0, c1;
            if (l == 0) { c0 = X[2 * j]; c1 = X[2 * j + 1]; }
            else { const v4u hv = H[j];
                c0 = (carrier4(hv.x, hv.z, si, si254, sic) - PR[256 + lane + 64 * (2 * j)]) * PR[lane + 64 * (2 * j)];
                c1 = (carrier4(hv.y, hv.w, si, si254, sic) - PR[256 + lane + 64 * (2 * j + 1)]) * PR[lane + 64 * (2 * j + 1)]; }
            const v4u yv = Y[j];
            tv[2 * j] = c0 * DN_ALPHA + pGt[2 * j] * (f32x4){bflo(yv.x), bfhi(yv.x), bflo(yv.y), bfhi(yv.y)};
            tv[2 * j + 1] = c1 * DN_ALPHA + pGt[2 * j + 1] * (f32x4){bflo(yv.z), bfhi(yv.z), bflo(yv.w), bfhi(yv.w)};
            s1 += ((tv[2 * j].x + tv[2 * j].y) + (tv[2 * j].z + tv[2 * j].w)) + ((tv[2 * j + 1].x + tv[2 * j + 1].y) + (tv[2 * j + 1].z + tv[2 * j + 1].w)); }
        if (reload) LNM_LOAD(X, H, Y, rr + 2);
        const float mean = wave_sum(s1) * (1.f / D); float s2 = 0.f;
#pragma unroll
        for (int j = 0; j < 4; ++j) { tv[j] = tv[j] - mean; s2 += (tv[j].x * tv[j].x + tv[j].y * tv[j].y) + (tv[j].z * tv[j].z + tv[j].w * tv[j].w); }
        const float rstd = frsq(wave_sum(s2) * (1.f / D) + LN_EPS);
        float lgt[NE]; float hmax = 0.f;
#pragma unroll
        for (int e = 0; e < NE; ++e) lgt[e] = 0.f;
#pragma unroll
        for (int j = 0; j < 2; ++j) {
#pragma unroll
            for (int h = 0; h < 2; ++h) { const int jj = 2 * j + h;
                const f32x4 hv = tv[jj] * rstd * pG2[jj] + pB2[jj];
                hmax = __builtin_fmaxf(hmax, __builtin_fmaxf(__builtin_fmaxf(__builtin_fabsf(hv.x), __builtin_fabsf(hv.y)), __builtin_fmaxf(__builtin_fabsf(hv.z), __builtin_fabsf(hv.w))));
                if (moe) { const int kk = 8 * lane + 512 * j + 4 * h;
#pragma unroll
                    for (int e = 0; e < NE; ++e) { const f32x4 r = *(const LAS f32x4*)(RW + e * D + kk); lgt[e] += (hv.x * r.x + hv.y * r.y) + (hv.z * r.z + hv.w * r.w); } } } }
        {
          const float rmax = wave_max_nonneg(hmax), qs = rmax > 0.f ? 127.0f / rmax : 0.f;
          GAS v2u* h8 = (GAS v2u*)(h8p + (size_t)R * D) + lane; GAS v2u* r8 = (GAS v2u*)(r8p + (size_t)R * D) + lane;
#pragma unroll
          for (int j = 0; j < 2; ++j) { const f32x4 h0 = (tv[2 * j] * rstd * pG2[2 * j] + pB2[2 * j]) * qs, h1 = (tv[2 * j + 1] * rstd * pG2[2 * j + 1] + pB2[2 * j + 1]) * qs;
              unsigned q0_, r0_, q1_, r1_; carrier_q4(h0, q0_, r0_); carrier_q4(h1, q1_, r1_); h8[64 * j] = (v2u){q0_, q1_}; r8[64 * j] = (v2u){r0_, r1_}; }
          sa_keep = (lane == rr) ? rmax * (1.0f / 127.0f) : sa_keep; }
        if (moe) {
            const float* rb = a->in[I_RB] + (l >> 1) * NE;
#pragma unroll
            for (int e = 0; e < NE; ++e) lgt[e] = wave_sum(lgt[e]) + rb[e];
            int e0 = 0; float v0 = lgt[0];
#pragma unroll
            for (int e = 1; e < NE; ++e) if (lgt[e] > v0) { v0 = lgt[e]; e0 = e; }
            int e1 = -1; float v1 = -3.0e38f;
#pragma unroll
            for (int e = 0; e < NE; ++e) if (e != e0 && lgt[e] > v1) { v1 = lgt[e]; e1 = e; }
            const float ex = __expf(v1 - v0), w0 = 1.f / (1.f + ex), w1 = ex / (1.f + ex);
            if (lane == 0) { E0[rl] = e0; E1[rl] = e1; W0[rl] = w0; W1[rl] = w1; }
        }
    };
    for (int rr = 0; rr < 30; rr += 2) { one_row(ax, ah, ay, rr, true); one_row(bx, bh, by, rr + 1, true); }
    one_row(ax, ah, ay, 30, false); one_row(bx, bh, by, 31, false);
    if (lane < 32) sap[ROW_OF(lane)] = sa_keep;
    if (moe) {
        __syncthreads();
        if (wave == 0) {
            int run[NE];
#pragma unroll
            for (int e = 0; e < NE; ++e) run[e] = 0;
            for (int q = 0; q < 8; ++q) { const int n = 64 * q + lane; const int e = (n & 1) ? E1[n >> 1] : E0[n >> 1]; int rank = 0;
#pragma unroll
                for (int x = 0; x < NE; ++x) { const unsigned long long mk = __ballot(e == x); const int below = __popcll(mk & ((1ull << lane) - 1ull));
                    if (e == x) rank = run[x] + below; run[x] += __popcll(mk); }
                LP[n] = rank; }
            if (lane < NE) { int cv = 0;
#pragma unroll
                for (int x = 0; x < NE; ++x) cv = (lane == x) ? run[x] : cv;
                ((int*)(a->ws + WS_WGCNT))[wg * NE + lane] = cv; }
        }
        __syncthreads();
        if (tid < 256) { const int R = wg * 256 + tid;
            ((int*)(a->ws + WS_TOKE))[R] = E0[tid] | (E1[tid] << 8); ((int*)(a->ws + WS_TOKP0))[R] = LP[2 * tid]; ((int*)(a->ws + WS_TOKP1))[R] = LP[2 * tid + 1];
            ((float*)(a->ws + WS_TOKW0))[R] = W0[tid]; ((float*)(a->ws + WS_TOKW1))[R] = W1[tid]; }
    }
}
__device__ __forceinline__ void moe_gather_phase(ArgP a, LAS unsigned char* lds, int wg, int tid) {
    const int lane = tid & 63, wave = __builtin_amdgcn_readfirstlane(tid >> 6);
    LAS int* TOTAL = (LAS int*)lds; LAS int* MYB = TOTAL + 8; LAS int* OFF = MYB + 8;
    const int* cnt = (const int*)(a->ws + WS_WGCNT);
    { const int e = wave; int c4[4]; int s = 0;
#pragma unroll
      for (int j = 0; j < 4; ++j) { c4[j] = cnt[(4 * lane + j) * NE + e]; s += c4[j]; }
      int incl = s;
#pragma unroll
      for (int o = 1; o < 64; o <<= 1) { const int t = __shfl_up(incl, o); if (lane >= o) incl += t; }
      const int excl = incl - s; const int total = __shfl(incl, 63);
      int mine = excl;
#pragma unroll
      for (int j = 0; j < 4; ++j) if (j < (wg & 3)) mine += c4[j];
      const int mb = __shfl(mine, wg >> 2);
      if (lane == 0) { TOTAL[e] = total; MYB[e] = mb; } }
    __syncthreads();
    if (tid == 0) { int o = 0; for (int e = 0; e < NE; ++e) { OFF[e] = o; o += (TOTAL[e] + 255) & ~255; }
        if (wg == 0) { int* pt = (int*)(a->ws + WS_PANEL); pt[0] = o >> 8; int p = 0; for (int e = 0; e < NE; ++e) { const int np = (TOTAL[e] + 255) >> 8; for (int i = 0; i < np; ++i) pt[16 + p++] = e; } } }
    __syncthreads();
    int* s2t = (int*)(a->ws + WS_S2T);
    if (wg < NE) { const int e = wg; for (int i = OFF[e] + TOTAL[e] + tid; i < OFF[e] + ((TOTAL[e] + 255) & ~255); i += 512) { s2t[i] = 0; ((float*)(a->ws + WS_SAS))[i] = 0.f; } }
    if (tid < 256) { const int R = wg * 256 + tid;
        const int ee = ((const int*)(a->ws + WS_TOKE))[R], e0 = ee & 255, e1 = ee >> 8;
        const int s0 = OFF[e0] + MYB[e0] + ((const int*)(a->ws + WS_TOKP0))[R], s1 = OFF[e1] + MYB[e1] + ((const int*)(a->ws + WS_TOKP1))[R];
        s2t[s0] = R; s2t[s1] = R; ((int*)(a->ws + WS_TOKP0))[R] = s0; ((int*)(a->ws + WS_TOKP1))[R] = s1;
        const float sr = ((const float*)(a->ws + WS_SA))[R]; ((float*)(a->ws + WS_SAS))[s0] = sr; ((float*)(a->ws + WS_SAS))[s1] = sr; }
}
__device__ __forceinline__ void ln_ffn_phase(ArgP a, int l, LAS unsigned char* lds, int wg, int tid) {
    const int lane = tid & 63, wave = __builtin_amdgcn_readfirstlane(tid >> 6);
    const bool moe = (l & 1) != 0, lastl = !(l + 1 < DEPTH);
    const float* mb = (const float*)(a->ws + WS_MOD) + ((size_t)l * BATCH + (wg >> 3)) * NMOD * D;
    const float* mn = (const float*)(a->ws + WS_MOD) + ((size_t)(lastl ? l : l + 1) * BATCH + (wg >> 3)) * NMOD * D;
    const bf16* fp = (const bf16*)(a->ws + (moe ? WS_F : WS_FD)); unsigned char* h8p = a->ws + WS_H8; unsigned char* r8p = a->ws + WS_R8; float* sap = (float*)(a->ws + WS_SA);
    f32x4 pInv[4], pSh[4], pGt[4], pG2[4], pB2[4];
#pragma unroll
    for (int jj = 0; jj < 4; ++jj) { const int o = 8 * lane + 512 * (jj >> 1) + 4 * (jj & 1);
        const f32x4 scf = *(const f32x4*)(mb + 4 * D + o), gt = *(const f32x4*)(mb + 5 * D + o);
        const f32x4 g = *(const f32x4*)(a->in[I_LNFG] + l * D + o), bb = *(const f32x4*)(a->in[I_LNFB] + l * D + o);
        pInv[jj] = (f32x4){frcp(1.f + scf.x), frcp(1.f + scf.y), frcp(1.f + scf.z), frcp(1.f + scf.w)}; pSh[jj] = *(const f32x4*)(mb + 3 * D + o); pGt[jj] = gt + 1.0f;
        if (lastl) { pG2[jj] = g; pB2[jj] = bb; }
        else { const f32x4 scn = *(const f32x4*)(mn + 1 * D + o), shn = *(const f32x4*)(mn + 0 * D + o); pG2[jj] = g * (scn + 1.0f); pB2[jj] = bb * (scn + 1.0f) + shn; } }
    int ms0 = 0, ms1 = 0; float mw0 = 1.f; float sa_in = 0.f;
    { const int Rl = ROW_OF(lane & 31); ms0 = Rl; ms1 = Rl; sa_in = sap[Rl];
      if (moe) { ms0 = ((const int*)(a->ws + WS_TOKP0))[Rl]; ms1 = ((const int*)(a->ws + WS_TOKP1))[Rl]; mw0 = ((const float*)(a->ws + WS_TOKW0))[Rl]; } }
    v4u ah[2], af0[2], af1[2], bh[2], bf0[2], bf1[2];
#define LNF_LOAD(H_, F0_, F1_, rr_) do { const int Rn = ROW_OF(rr_); const int s0n = __shfl(ms0, (rr_)), s1n = __shfl(ms1, (rr_)); \
        const GAS v2u* hq_ = (const GAS v2u*)(h8p + (size_t)Rn * D) + lane; const GAS v2u* hr_ = (const GAS v2u*)(r8p + (size_t)Rn * D) + lane; const GAS v4u* f0_ = (const GAS v4u*)(fp + (size_t)s0n * D) + lane; const GAS v4u* f1_ = (const GAS v4u*)(fp + (size_t)s1n * D) + lane; \
        _Pragma("unroll") for (int j = 0; j < 2; ++j) { const v2u q_ = hq_[64 * j], r_ = hr_[64 * j]; H_[j] = (v4u){q_.x, q_.y, r_.x, r_.y}; F0_[j] = f0_[64 * j]; if (moe) F1_[j] = f1_[64 * j]; } } while (0)
#define LNF_UNP(w_, h_) ((h_) == 0 ? (f32x4){bflo((w_).x), bfhi((w_).x), bflo((w_).y), bfhi((w_).y)} : (f32x4){bflo((w_).z), bfhi((w_).z), bflo((w_).w), bfhi((w_).w)})
    LNF_LOAD(ah, af0, af1, 0); LNF_LOAD(bh, bf0, bf1, 1);
    ROW0_LANDED4(pInv); ROW0_LANDED4(pSh); ROW0_LANDED4(pGt); ROW0_LANDED4(pG2); ROW0_LANDED4(pB2); asm volatile("" :: "v"(ms0), "v"(ms1), "v"(mw0), "v"(sa_in));
    ROW0_LANDED2(ah); ROW0_LANDED2(af0); ROW0_LANDED2(bh); ROW0_LANDED2(bf0); if (moe) { ROW0_LANDED2(af1); ROW0_LANDED2(bf1); }
    float sa_keep = 0.f;
    auto one_row = [&](v4u (&H)[2], v4u (&F0)[2], v4u (&F1)[2], const int rr, const bool reload) __attribute__((always_inline)) {
        const int R = ROW_OF(rr);
        const float w0 = __shfl(mw0, rr), w1 = 1.0f - w0;
        const float si = __shfl(sa_in, rr), si254 = si * (1.0f / 254.0f), sic = -128.0f * si - 128.0f * si254;
        f32x4 tv[4];
        float s1 = 0.f;
#pragma unroll
        for (int jj = 0; jj < 4; ++jj) { const int j = jj >> 1, h = jj & 1; f32x4 fv = LNF_UNP(F0[j], h) * w0;
            if (moe) fv += LNF_UNP(F1[j], h) * w1;
            const f32x4 xv = (carrier4(h == 0 ? H[j].x : H[j].y, h == 0 ? H[j].z : H[j].w, si, si254, sic) - pSh[jj]) * pInv[jj];
            tv[jj] = xv * DN_ALPHA + pGt[jj] * fv; s1 += (tv[jj].x + tv[jj].y) + (tv[jj].z + tv[jj].w); }
        if (reload) LNF_LOAD(H, F0, F1, rr + 2);
        const float mean = wave_sum(s1) * (1.f / D); float s2 = 0.f;
#pragma unroll
        for (int j = 0; j < 4; ++j) { tv[j] = tv[j] - mean; s2 += (tv[j].x * tv[j].x + tv[j].y * tv[j].y) + (tv[j].z * tv[j].z + tv[j].w * tv[j].w); }
        const float rstd = frsq(wave_sum(s2) * (1.f / D) + LN_EPS);
        if (!lastl) { float hmax = 0.f;
#pragma unroll
            for (int j = 0; j < 4; ++j) { const f32x4 hv = tv[j] * rstd * pG2[j] + pB2[j];
                hmax = __builtin_fmaxf(hmax, __builtin_fmaxf(__builtin_fmaxf(__builtin_fabsf(hv.x), __builtin_fabsf(hv.y)), __builtin_fmaxf(__builtin_fabsf(hv.z), __builtin_fabsf(hv.w)))); }
            const float rmax = wave_max_nonneg(hmax), qs = rmax > 0.f ? 127.0f / rmax : 0.f;
            GAS v2u* h8 = (GAS v2u*)(h8p + (size_t)R * D) + lane; GAS v2u* r8 = (GAS v2u*)(r8p + (size_t)R * D) + lane;
#pragma unroll
            for (int j = 0; j < 2; ++j) { unsigned q0_, r0_, q1_, r1_;
                carrier_q4((tv[2 * j] * rstd * pG2[2 * j] + pB2[2 * j]) * qs, q0_, r0_); carrier_q4((tv[2 * j + 1] * rstd * pG2[2 * j + 1] + pB2[2 * j + 1]) * qs, q1_, r1_);
                h8[64 * j] = (v2u){q0_, q1_}; r8[64 * j] = (v2u){r0_, r1_}; }
            sa_keep = (lane == rr) ? rmax * (1.0f / 127.0f) : sa_keep; }
        else { GAS f32x4* xo = (GAS f32x4*)(a->out + (size_t)R * D) + 2 * lane;
#pragma unroll
            for (int jj = 0; jj < 4; ++jj) xo[128 * (jj >> 1) + (jj & 1)] = tv[jj] * rstd * pG2[jj] + pB2[jj]; }
    };
    for (int rr = 0; rr < 30; rr += 2) { one_row(ah, af0, af1, rr, true); one_row(bh, bf0, bf1, rr + 1, true); }
    one_row(ah, af0, af1, 30, false); one_row(bh, bf0, bf1, 31, false);
    if (!lastl && lane < 32) sap[ROW_OF(lane)] = sa_keep;
#undef LNF_LOAD
#undef LNF_UNP
}

__device__ __forceinline__ void grid_bar_now(LAS unsigned char* lds) { if (MK_N_LAUNCHES == 1) { XcdBarrier b_; b_.bar = (unsigned*)(argp()->ws + WS_CTL) + CW_BAR; b_.x = xb_xcc_id(); b_.st = (volatile LAS unsigned*)(lds + MISC_OFF) + 8; xcd_barrier(b_); } }
#define REP_LOOP(k) for (int rep_ = 0; rep_ < REPS(k); ++rep_, (rep_ < REPS(k) ? grid_bar_now(lds) : (void)0))
#define STEP_IN (lo <= step && step < hi)
#define STEP_END do { if (MK_N_LAUNCHES == 1 && STEP_IN && step + 1 < hi) { XcdBarrier b_; b_.bar = (unsigned*)(argp()->ws + WS_CTL) + CW_BAR; b_.x = xb_xcc_id(); b_.st = (volatile LAS unsigned*)(lds + MISC_OFF) + 8; xcd_barrier(b_); } ++step; } while (0)
#define PHASE_IDS const int tid = wave_id_ * 64 + lane_id_volatile(), wg = opaque_s((int)blockIdx.x), G = opaque_s((int)gridDim.x); (void)tid; (void)wg; (void)G
template <int l> __device__ __forceinline__ void layer_steps(LAS unsigned char* lds, const int lo, const int hi, int& step, const int wave_id_) {
        constexpr bool moe = (l & 1) != 0;
        if (PH(2) && STEP_IN) REP_LOOP(2) {
            PHASE_IDS; ArgP ap = argp(); unsigned char* ws = ap->ws;
            const pg8::Gemm g = pg8::mk_gemm(D / 2, D / 2, D / 2);
            pg8::SchedPlain S{(const char*)(ws + WS_H8), (const char*)(ws + WS_WIN) + (size_t)l * NIN * D * 2, M / 256, NIN / 256, G, wg, 256u * D, 256u * D};
            pg8::EpiInProj E{ws, ap->in[I_BALPHA] + l * GDK, (const float*)(ws + WS_SA), (const float*)(ws + WS_SWIN) + l * NIN};
            pg8::gemm_phase<pg8::EpiInProj, pg8::SchedPlain, true, true, false, false, true>(lds, g, S, E, tid);
        }
        STEP_END;
        if (PH(3) && STEP_IN) REP_LOOP(3) {
            PHASE_IDS; ArgP ap = argp(); unsigned char* ws = ap->ws;
            const pg8::Gemm g = pg8::mk_gemm(S5KU, S5LDA, S5KU); pg8::SchedGroup S{(const char*)(ws + WS_AEXT), (const char*)(ws + WS_CTRL) + (size_t)l * S5G * 256 * S5KU * 2, S5G * 8, 1, G, wg, 256u * S5LDA * 2, 0u, 256u * S5KU * 2};
            pg8::EpiS1 E{(float*)(ws + WS_SLOC)};
            pg8::gemm_phase<pg8::EpiS1, pg8::SchedGroup>(lds, g, S, E, tid);
            pg8::Unit u0;
            if (S.next(0, u0)) {
                __builtin_amdgcn_fence(__ATOMIC_ACQUIRE, "agent"); asm volatile("s_waitcnt vmcnt(0)" ::: "memory"); __syncthreads();
                if (tid < 256) {
                    const int p = tid & 63, grp = u0.pm >> 3, r0 = u0.pm * 256 + (tid >> 6) * S5NC;
                    const float* lt = (const float*)(ws + WS_LAMT) + ((size_t)(l * S5G + grp) * S5P + p) * 2; const float lr = lt[0], li = lt[1];
                    const float* sloc = (const float*)(ws + WS_SLOC) + (size_t)r0 * 128;
                    bf16* ae = (bf16*)(ws + WS_AEXT) + (size_t)r0 * S5LDA + S5KU;
                    float hr = 0.f, hi_ = 0.f;
                    static_assert(S5NC == 64, "carry scan batches");
                    float sra[32], sia[32], srb[32], sib[32];
#pragma unroll
                    for (int c = 0; c < 32; ++c) { sra[c] = sloc[(size_t)c * 128 + p]; sia[c] = sloc[(size_t)c * 128 + 64 + p]; }
#pragma unroll
                    for (int c = 0; c < 32; ++c) { srb[c] = sloc[(size_t)(32 + c) * 128 + p]; sib[c] = sloc[(size_t)(32 + c) * 128 + 64 + p]; }
#pragma unroll
                    for (int c = 0; c < 32; ++c) { ae[(size_t)c * S5LDA + p] = (bf16)f2bf(hr); ae[(size_t)c * S5LDA + 64 + p] = (bf16)f2bf(hi_);
                        const float nr = lr * hr - li * hi_ + sra[c], ni = lr * hi_ + li * hr + sia[c]; hr = nr; hi_ = ni; }
#pragma unroll
                    for (int c = 0; c < 32; ++c) { ae[(size_t)(32 + c) * S5LDA + p] = (bf16)f2bf(hr); ae[(size_t)(32 + c) * S5LDA + 64 + p] = (bf16)f2bf(hi_);
                        const float nr = lr * hr - li * hi_ + srb[c], ni = lr * hi_ + li * hr + sib[c]; hr = nr; hi_ = ni; }
                }
            }
        }
        STEP_END;
        if (STEP_IN) REP_LOOP(5) {
            PHASE_IDS;
            if (wg < 128) { if (PH(5)) for (int gr_ = 0; gr_ < GLA_REPS; ++gr_) gla_phase(argp(), l, lds, wg, tid); }
            else if (PH(6)) {
                { ArgP ap = argp(); unsigned char* ws = ap->ws;
                  const pg8::Gemm g = pg8::mk_gemm(S5LDA, S5LDA, S5LDA); pg8::SchedGroupS5 S{(const char*)(ws + WS_AEXT), (const char*)(ws + WS_TOEP) + (size_t)l * S5G * S5KU * S5LDA * 2, S5G * 8, 2, G - 128, wg - 128, 256u * S5LDA * 2, 256u * S5LDA * 2, (unsigned)S5KU * S5LDA * 2};
                  pg8::EpiS5 E{(const bf16*)(ws + WS_AEXT), ap->in[I_SD] + l * S5W, (bf16*)(ws + WS_YS5)};
                  pg8::gemm_phase<pg8::EpiS5, pg8::SchedGroupS5>(lds, g, S, E, tid); }
                { unsigned* ctl = (unsigned*)(argp()->ws + WS_CTL); sub_barrier(ctl + CW_SUB + 64 * l, (unsigned)(G - 128), ctl + CW_BAR); }
                { const int tid2 = wave_id_ * 64 + lane_id_volatile(), wg2 = opaque_s(wg), G2 = opaque_s(G); ArgP ap = argp(); unsigned char* ws = ap->ws;
                  const pg8::Gemm g{S5W, 32u, (unsigned)M * 32u, 4u * (unsigned)M * 32u, (unsigned)S5W};
                  pg8::SchedPlain S{(const char*)(ws + WS_YS5), (const char*)(ws + WS_WGLU) + (size_t)l * S5W * S5W * 2, M / 256, 2, G2 - 128, wg2 - 128, 256u * 32u, 256u * S5W * 2};
                  pg8::EpiGlu E{(const bf16*)(ws + WS_YS5), ap->in[I_BGLU] + l * S5W, (bf16*)(ws + WS_YCAT)};
                  pg8::gemm_phase<pg8::EpiGlu, pg8::SchedPlain>(lds, g, S, E, tid2); }
            }
        }
        STEP_END;
        if (PH(8) && STEP_IN) REP_LOOP(8) {
            PHASE_IDS; ArgP ap = argp(); unsigned char* ws = ap->ws;
            const pg8::Gemm g = pg8::mk_gemm(D, D, D); pg8::SchedPlain S{(const char*)(ws + WS_YCAT), (const char*)(ws + WS_WOUT) + (size_t)l * D * D * 2, M / 256, 4, G, wg, 256u * D * 2, 256u * D * 2};
            pg8::EpiPlain E{(bf16*)ap->out, D, 1.0f};
            pg8::gemm_phase<pg8::EpiPlain, pg8::SchedPlain>(lds, g, S, E, tid);
        }
        STEP_END;
        if (PH(9) && STEP_IN) { PHASE_IDS; ln_mix_phase(argp(), l, lds, wg, tid); }
        STEP_END;
        if constexpr (moe) {
            if (PH(10) && STEP_IN) { PHASE_IDS; moe_gather_phase(argp(), lds, wg, tid); }
            STEP_END;
            if (PH(11) && STEP_IN) REP_LOOP(13) {
                PHASE_IDS; ArgP ap = argp(); unsigned char* ws = ap->ws;
                const int npan = __builtin_amdgcn_readfirstlane(((const int*)(ws + WS_PANEL))[0]);
                const pg8::Gemm g = pg8::mk_gemm(D / 2, D / 2, D / 2);
                pg8::SchedExpert S{(const char*)(ws + WS_H8), (const char*)(ws + WS_WMOE), (const int*)(ws + WS_PANEL) + 16, 0, npan - 256, DFF / 128, G, wg, 256u * D, 256u * D, (unsigned)WMOE_E, 0, (const int*)(ws + WS_S2T), 0, 0};
                pg8::EpiGateUpI8 E{ws + WS_ACT, 0, (const float*)(ws + WS_SAS), (const int*)(ws + WS_S2T), (const float*)(ws + WS_SW) + 2 * DFF, (const int*)(ws + WS_PANEL) + 16};
                pg8::gemm_phase<pg8::EpiGateUpI8, pg8::SchedExpert, true, true, false, true, true>(lds, g, S, E, tid);
            }
            STEP_END;
            if (PH(12) && STEP_IN) REP_LOOP(14) {
                PHASE_IDS;
                { ArgP ap = argp(); unsigned char* ws = ap->ws;
                  const int npan = __builtin_amdgcn_readfirstlane(((const int*)(ws + WS_PANEL))[0]);
                  const pg8::Gemm g = pg8::mk_gemm(DFF / 2, DFF / 2, DFF / 2);
                  pg8::SchedExpert S{(const char*)(ws + WS_ACT), (const char*)(ws + WS_WMOE) + WMOE_D, (const int*)(ws + WS_PANEL) + 16, 0, npan - 256, D / 256, G, wg, 256u * DFF, 256u * DFF, (unsigned)WMOE_E, 1, nullptr, 0, 0};
                  pg8::EpiPlain E{(bf16*)(ws + WS_F), D, 1.0f / (pg8::ACT_SCALE * pg8::WD_SCALE)};
                  pg8::gemm_phase<pg8::EpiPlain, pg8::SchedExpert, true, true, true>(lds, g, S, E, tid); }
                { const int tid2 = wave_id_ * 64 + lane_id_volatile(), wg2 = opaque_s(wg), G2 = opaque_s(G); ArgP ap = argp(); unsigned char* ws = ap->ws;
                  const int npan = __builtin_amdgcn_readfirstlane(((const int*)(ws + WS_PANEL))[0]);
                  const int nb5 = 4 * (npan - 256) - 4 * G2;
                  const pg8::Gemm g = pg8::mk_gemm(D / 2, D / 2, D / 2);
                  pg8::SchedExpert S{(const char*)(ws + WS_H8), (const char*)(ws + WS_WMOE), (const int*)(ws + WS_PANEL) + 16, npan - 256, 256, DFF / 128, G2, wg2, 256u * D, 256u * D, (unsigned)WMOE_E, 0, (const int*)(ws + WS_S2T), nb5 > 0 ? nb5 : 0, DFF / 128 - 2};
                  pg8::EpiGateUpI8 E{(unsigned char*)ap->out, npan - 256, (const float*)(ws + WS_SAS), (const int*)(ws + WS_S2T), (const float*)(ws + WS_SW) + 2 * DFF, (const int*)(ws + WS_PANEL) + 16};
                  pg8::gemm_phase<pg8::EpiGateUpI8, pg8::SchedExpert, true, true, false, true, true>(lds, g, S, E, tid2); }
            }
            STEP_END;
            if (PH(12) && STEP_IN) REP_LOOP(15) {
                PHASE_IDS; ArgP ap = argp(); unsigned char* ws = ap->ws;
                const int npan = __builtin_amdgcn_readfirstlane(((const int*)(ws + WS_PANEL))[0]);
                const pg8::Gemm g = pg8::mk_gemm(DFF / 2, DFF / 2, DFF / 2);
                pg8::SchedExpert S{(const char*)ap->out, (const char*)(ws + WS_WMOE) + WMOE_D, (const int*)(ws + WS_PANEL) + 16, npan - 256, 256, D / 256, G, wg, 256u * DFF, 256u * DFF, (unsigned)WMOE_E, 1, nullptr, 0, 0};
                pg8::EpiPlain E{(bf16*)(ws + WS_F), D, 1.0f / (pg8::ACT_SCALE * pg8::WD_SCALE)};
                pg8::gemm_phase<pg8::EpiPlain, pg8::SchedExpert, true, true, true>(lds, g, S, E, tid);
            }
            STEP_END;
            if (PH(13) && STEP_IN) { PHASE_IDS; ln_ffn_phase(argp(), l, lds, wg, tid); }
            STEP_END;
        } else {
            if (PH(11) && STEP_IN) REP_LOOP(11) {
                PHASE_IDS; ArgP ap = argp(); unsigned char* ws = ap->ws;
                const pg8::Gemm g = pg8::mk_gemm(D / 2, D / 2, D / 2);
                pg8::SchedExpert S{(const char*)(ws + WS_H8), (const char*)(ws + WS_WDEN), nullptr, 0, M / 256, DFF / 128, G, wg, 256u * D, 256u * D, 0u, 0, nullptr, 0, 0};
                pg8::EpiGateUpI8 E{ws + WS_F, 0, (const float*)(ws + WS_SA), nullptr, (const float*)(ws + WS_SW), nullptr};
                pg8::gemm_phase<pg8::EpiGateUpI8, pg8::SchedExpert, true, true, false, false, true>(lds, g, S, E, tid);
            }
            STEP_END;
            if (PH(12) && STEP_IN) REP_LOOP(12) {
                PHASE_IDS; ArgP ap = argp(); unsigned char* ws = ap->ws;
                const pg8::Gemm g = pg8::mk_gemm(DFF / 2, DFF / 2, DFF / 2);
                pg8::SchedExpert S{(const char*)(ws + WS_F), (const char*)(ws + WS_WDEN) + WMOE_D, nullptr, 0, M / 256, D / 256, G, wg, 256u * DFF, 256u * DFF, 0u, 1, nullptr, 0, 0};
                pg8::EpiPlain E{(bf16*)(ws + WS_FD), D, 1.0f / (pg8::ACT_SCALE * pg8::WD_SCALE)};
                pg8::gemm_phase<pg8::EpiPlain, pg8::SchedExpert, true, true, true>(lds, g, S, E, tid);
            }
            STEP_END;
            if (PH(13) && STEP_IN) { PHASE_IDS; ln_ffn_phase(argp(), l, lds, wg, tid); }
            STEP_END;
        }
    }

__global__ void __launch_bounds__(NWAVES * 64, 2) fwd(Args args) {
    extern __shared__ __attribute__((aligned(16))) unsigned char lds_raw[];
    LAS unsigned char* lds = (LAS unsigned char*)lds_raw;
    for (int u = threadIdx.x; u < (LDS_BYTES - LDSCTL_OFF) / 4; u += NWAVES * 64) ((LAS unsigned*)(lds + LDSCTL_OFF))[u] = 0u;
    __syncthreads();
    if (MK_N_LAUNCHES == 1) (void)xcd_barrier_post((unsigned*)(argp()->ws + WS_CTL) + CW_BAR, (volatile LAS unsigned*)(lds + MISC_OFF) + 8);
    const int lo = args.lo, hi = args.hi;
    int step = 0;
    const int wave_id_ = opaque_s(__builtin_amdgcn_readfirstlane((int)threadIdx.x >> 6));

    if (PH(1) && STEP_IN) REP_LOOP(1) {
        PHASE_IDS; const int lane = tid & 63, wave = __builtin_amdgcn_readfirstlane(tid >> 6); ArgP ap = argp(); unsigned char* ws = ap->ws;
        unsigned* ctl = (unsigned*)(ws + WS_CTL);
        for (int r_ = 0; r_ < REPS(16); ++r_) { prologue_mod(ap, lds, wg, G, tid);
        prologue_comb(ap, lds, wg, tid); }
        asm volatile("s_waitcnt vmcnt(0)" ::: "memory"); __syncthreads();
        if (tid == 0) { __builtin_amdgcn_fence(__ATOMIC_RELEASE, "agent"); asm volatile("s_waitcnt vmcnt(0)" ::: "memory"); (void)xb_add(ctl + CW_SUB + 64 * 4, 1u); }
        for (int r_ = 0; r_ < REPS(17); ++r_) if (wg < 2 * S5G) prologue_s5(ap, lds, wg, tid);
        for (int r_ = 0; r_ < REPS(18); ++r_) prologue_strips(ap, lds, wg, G, wave, lane);
        const int nslots = (2 * (G - 64) + 64) * NWAVES;
        for (int r_ = 0; r_ < REPS(19); ++r_) if (wg < 64) prologue_transposes(ap, lds, wg * NWAVES + wave, -1, nslots, wave, lane);
        else prologue_transposes(ap, lds, (64 + 2 * (wg - 64)) * NWAVES + wave, (65 + 2 * (wg - 64)) * NWAVES + wave, nslots, wave, lane);
        if (tid == 0) { XB_SPIN(xb_ld(ctl + CW_SUB + 64 * 4) < (unsigned)G, ctl + CW_BAR); __builtin_amdgcn_fence(__ATOMIC_ACQUIRE, "agent"); asm volatile("s_waitcnt vmcnt(0)" ::: "memory"); }
        __syncthreads();
        for (int r_ = 0; r_ < REPS(20); ++r_) hmod_rows(ap->in[I_X], (const float*)(ws + WS_MOD), 0, D, (bf16*)(ws + WS_HMOD), ws, wg, wave, lane);
    }
    STEP_END;

    layer_steps<0>(lds, lo, hi, step, wave_id_);
    layer_steps<1>(lds, lo, hi, step, wave_id_);
}
#undef STEP_IN
#undef STEP_END

constexpr int N_STEPS = 1 + (5 + 3) + (5 + 1 + 3 + 1);

extern "C" void kernel_launch(void* const* d_in, const int* in_sizes, int n_in, void* d_out, int out_size, void* d_ws, size_t ws_size, hipStream_t stream) {
    static int grid = 0;
    if (grid == 0) {
        if (n_in != 31 || in_sizes[0] != M * D || out_size != M * D || ws_size < WS_END) { fprintf(stderr, "kernel_launch: unexpected shapes / workspace (n_in %d, ws %zu); nothing launched\n", n_in, ws_size); grid = -1; return; }
        int dev = 0, cus = 0, per_cu = 0;
        if (hipGetDevice(&dev) != hipSuccess || hipDeviceGetAttribute(&cus, hipDeviceAttributeMultiprocessorCount, dev) != hipSuccess) { grid = -1; return; }
        if (hipFuncSetAttribute((const void*)fwd, hipFuncAttributeMaxDynamicSharedMemorySize, LDS_BYTES) != hipSuccess) { fprintf(stderr, "kernel_launch: hipFuncSetAttribute failed\n"); grid = -1; return; }
        if (hipOccupancyMaxActiveBlocksPerMultiprocessor(&per_cu, (const void*)fwd, NWAVES * 64, LDS_BYTES) != hipSuccess || per_cu < 1) fprintf(stderr, "kernel_launch: occupancy query reports %d\n", per_cu);
        (void)hipGetLastError();
        grid = cus;
        if (grid != 256) { fprintf(stderr, "kernel_launch: built for 256 CUs, found %d\n", cus); grid = -1; return; }
    }
    if (grid < 0) return;
    if (hipMemsetAsync((char*)d_ws + WS_CTL, 0, CTL_ZERO_BYTES, stream) != hipSuccess) return;
    Args a{};
    for (int i = 0; i < 31; ++i) a.in[i] = (const float*)d_in[i];
    a.out = (float*)d_out; a.ws = (unsigned char*)d_ws;
    if (MK_N_LAUNCHES == 1) { a.lo = 0; a.hi = N_STEPS; hipLaunchKernelGGL(fwd, dim3(grid), dim3(NWAVES * 64), LDS_BYTES, stream, a); }
    else for (int s = 0; s < N_STEPS; ++s) { a.lo = s; a.hi = s + 1; hipLaunchKernelGGL(fwd, dim3(grid), dim3(NWAVES * 64), LDS_BYTES, stream, a); }
}
```

```cpp
#include <hip/hip_runtime.h>
#include <cstdio>
#include <cstdint>

#ifndef PH_MASK
#define PH_MASK 0xFFFF
#endif
#define PH(k) ((PH_MASK >> (k)) & 1)
#ifndef GLA_REPS
#define GLA_REPS 1
#endif
#ifndef GLA_PROD_REPS
#define GLA_PROD_REPS 1
#endif
#ifndef REP_MASK
#define REP_MASK 0
#endif
#define REPS(k) (((REP_MASK >> (k)) & 1) ? 2 : 1)
#ifndef MK_N_LAUNCHES
#define MK_N_LAUNCHES 1
#endif

constexpr int D = 1024, BATCH = 32, SEQ = 2048, M = BATCH * SEQ, DEPTH = 2;
constexpr int S5W = 512, S5G = 32, S5H = 16, S5P = 64, S5T = 32;
constexpr int S5NC = SEQ / S5T;
constexpr int S5ROWS = BATCH * S5NC;
constexpr int S5KU = S5T * S5H;
constexpr int S5LDA = S5KU + 2 * S5P;
constexpr int GDK = 256, GHK = 64, GHV = 128, GNH = 4, GRANK = 16, GCH = 64, GW = 512;
constexpr int INCOLS = 2064, NIN = 2304;
constexpr int DFF = 3584, NE = 8;
constexpr float LN_EPS = 1e-5f, RMS_EPS = 1e-6f;
constexpr float DN_ALPHA = 1.41421356237309515f;
constexpr int NMOD = 6;
constexpr int NWAVES = 8;

constexpr size_t MiB = 1u << 20;
constexpr size_t WS_CTL = 0, CTL_ZERO_BYTES = 64 * 1024;
constexpr size_t WS_MOD = 1 * MiB;
constexpr size_t WS_TOKE = 3 * MiB;
constexpr size_t WS_TOKP0 = WS_TOKE + 256 * 1024, WS_TOKP1 = WS_TOKP0 + 256 * 1024;
constexpr size_t WS_TOKW0 = WS_TOKP1 + 256 * 1024, WS_TOKW1 = WS_TOKW0 + 256 * 1024;
constexpr size_t WS_WGCNT = WS_TOKW1 + 256 * 1024;
constexpr size_t WS_PANEL = WS_WGCNT + 16 * 1024;
constexpr size_t WS_LAMT = WS_PANEL + 16 * 1024;
constexpr size_t WS_S2T = 8 * MiB;
constexpr size_t WS_SA = 9 * MiB;
constexpr size_t WS_SW = 10 * MiB;
constexpr size_t WS_SAS = 12 * MiB;
constexpr size_t WS_SWIN = 11 * MiB;
constexpr size_t WS_WMOE = 16 * MiB;
constexpr size_t WMOE_E = 21 * MiB, WMOE_D = 14 * MiB;
constexpr size_t WS_WIN = 184 * MiB;
constexpr size_t WS_WOUT = WS_WIN + 9 * MiB;
constexpr size_t WS_WGLU = WS_WOUT + 4 * MiB;
constexpr size_t WS_WDEN = WS_WGLU + 1 * MiB;
constexpr size_t WS_CTRL = WS_WDEN + 21 * MiB;
constexpr size_t WS_TOEP = WS_CTRL + 16 * MiB;
static_assert(WS_TOEP + 40 * MiB <= 280 * MiB, "static region");
constexpr size_t WS_R8 = 344 * MiB;
constexpr size_t WS_HMOD = 280 * MiB;
constexpr size_t WS_AEXT = 408 * MiB;
constexpr size_t WS_Q = 488 * MiB, WS_K = 520 * MiB, WS_V = 552 * MiB, WS_GO = 616 * MiB;
constexpr size_t WS_LA = 680 * MiB;
constexpr size_t WS_YS5 = 744 * MiB;
constexpr size_t WS_YCAT = 808 * MiB;
constexpr size_t WS_SLOC = 936 * MiB;
constexpr size_t WS_F = 408 * MiB;
constexpr size_t WS_FD = 632 * MiB;
constexpr size_t WS_H8 = 280 * MiB;
constexpr size_t WS_ACT = 668 * MiB;
constexpr size_t WS_END = 1024 * MiB;
static_assert(WS_SLOC + 32 * MiB <= WS_END && WS_ACT + (size_t)264 * 256 * DFF <= WS_END && WS_F + (size_t)520 * 256 * D * 2 <= WS_ACT, "ws map");
constexpr int CW_SUB = 8192;
constexpr int CW_BAR = 4096;
constexpr int SLICE_P = 256;

constexpr int RING_BYTES = 131072;
constexpr int LDSCTL_OFF = RING_BYTES, MISC_OFF = LDSCTL_OFF + 320;
constexpr int LDS_BYTES = 147456;

#define GAS __attribute__((address_space(1)))
#define LAS __attribute__((address_space(3)))
typedef unsigned short bf16;
typedef unsigned v4u __attribute__((ext_vector_type(4)));
typedef unsigned v2u __attribute__((ext_vector_type(2)));
typedef float f32x4 __attribute__((ext_vector_type(4)));
typedef float f32x2 __attribute__((ext_vector_type(2)));
typedef short bf16x8 __attribute__((ext_vector_type(8)));
#define LDS_WAIT() asm volatile("s_waitcnt lgkmcnt(0)" ::: "memory")
#define VM_WAIT() asm volatile("s_waitcnt vmcnt(0)" ::: "memory")
__device__ __forceinline__ unsigned f2bf(float f) { unsigned u = __builtin_bit_cast(unsigned, f); return (u + 0x7fffu + ((u >> 16) & 1u)) >> 16; }
typedef __bf16 bf16v2_t __attribute__((ext_vector_type(2)));
__device__ __forceinline__ unsigned pk2(float lo, float hi) { const f32x2 v = {lo, hi}; const bf16v2_t b = __builtin_convertvector(v, bf16v2_t); return __builtin_bit_cast(unsigned, b); }
__device__ __forceinline__ float frcp(float x) { return __builtin_amdgcn_rcpf(x); }
__device__ __forceinline__ float frsq(float x) { return __builtin_amdgcn_rsqf(x); }
__device__ __forceinline__ float bflo(unsigned w) { return __builtin_bit_cast(float, w << 16); }
__device__ __forceinline__ float bfhi(unsigned w) { return __builtin_bit_cast(float, w & 0xffff0000u); }
__device__ __forceinline__ float bf2f(bf16 h) { return __builtin_bit_cast(float, ((unsigned)h) << 16); }
#define DPP_F(v, ctrl, rmask) __builtin_bit_cast(float, __builtin_amdgcn_update_dpp(0, __builtin_bit_cast(int, (v)), (ctrl), (rmask), 0xF, false))
__device__ __forceinline__ float wave_sum(float v) {
    v += DPP_F(v, 0xB1, 0xF);
    v += DPP_F(v, 0x4E, 0xF);
    v += DPP_F(v, 0x141, 0xF);
    v += DPP_F(v, 0x140, 0xF);
    v += DPP_F(v, 0x142, 0xA);
    v += DPP_F(v, 0x143, 0xC);
    return __builtin_bit_cast(float, __builtin_amdgcn_readlane(__builtin_bit_cast(int, v), 63));
}
#ifndef Q8_EMU
#define Q8_EMU 0
#endif
__device__ __forceinline__ float q8emu(float x, float s) {
    if (!Q8_EMU) return x;
    float y = x * s; const float a = fabsf(y);
    if (a >= 0.015625f) { unsigned u = __builtin_bit_cast(unsigned, y); u = (u + 0x7FFFFu + ((u >> 20) & 1u)) & ~0xFFFFFu; y = __builtin_bit_cast(float, u); }
    else y = rintf(y * 512.0f) * (1.0f / 512.0f);
    y = fminf(fmaxf(y, -448.f), 448.f);
    return y / s;
}
__device__ __forceinline__ float sigmoidf_(float x) { return frcp(1.0f + __expf(-x)); }
__device__ __forceinline__ float siluf_(float x) { return x * frcp(1.0f + __expf(-x)); }
__device__ __forceinline__ float gelu_tanh(float x) {
    const float a2 = x * x * (-2.0f * 0.7978845608028654f * 0.044715f * 1.4426950408889634f) + (-2.0f * 0.7978845608028654f * 1.4426950408889634f);
    return x * frcp(1.0f + __builtin_amdgcn_exp2f(x * a2));
}

__device__ __forceinline__ float wave_max_nonneg(float v) {
    v = __builtin_fmaxf(v, DPP_F(v, 0xB1, 0xF)); v = __builtin_fmaxf(v, DPP_F(v, 0x4E, 0xF)); v = __builtin_fmaxf(v, DPP_F(v, 0x141, 0xF)); v = __builtin_fmaxf(v, DPP_F(v, 0x140, 0xF));
    v = __builtin_fmaxf(v, DPP_F(v, 0x142, 0xA)); v = __builtin_fmaxf(v, DPP_F(v, 0x143, 0xC));
    return __builtin_bit_cast(float, __builtin_amdgcn_readlane(__builtin_bit_cast(int, v), 63));
}
__device__ __forceinline__ unsigned pk4_i8(float a, float b, float c, float d) {
    const int ia = (int)__builtin_rintf(a), ib = (int)__builtin_rintf(b), ic = (int)__builtin_rintf(c), id = (int)__builtin_rintf(d);
    return ((unsigned)ia & 0xffu) | (((unsigned)ib & 0xffu) << 8) | (((unsigned)ic & 0xffu) << 16) | ((unsigned)id << 24);
}
namespace pg8 {
#define PG8_LAS __attribute__((address_space(3)))
typedef unsigned short bf16_t;
constexpr int BM = 256, BK = 64, HALF = 128, HTB = HALF * BK * 2, STAGE_BYTES = 8 * HTB, NXCD = 8, WGM = 8;
__host__ __device__ __forceinline__ int lds_byte(int r, int c) { const int st = (r >> 4) * 2 + (c >> 5), rr = r & 15, cc = c & 31, ob = rr * 64 + cc * 2; return st * 1024 + (ob ^ (((ob >> 9) & 1) << 5)); }
__host__ __device__ __forceinline__ void stage_rc(int b, int& R, int& C) { const int st = b / 1024, sb = b % 1024, swz = sb ^ (((sb >> 9) & 1) << 5); R = (st >> 1) * 16 + swz / 64; C = (st & 1) * 32 + (swz % 64) / 2; }
__host__ __device__ __forceinline__ int perm32(int rho) { const int n = rho >> 4, i = rho & 15; return 8 * (i >> 2) + 4 * n + (i & 3); }

struct Unit { const char* a; const char* b; int pm, pn; const int* rows; };
struct Gemm { int K; unsigned a_row, a_grp, a_kstep, ldb; };
__device__ __forceinline__ Gemm mk_gemm(int K, int lda, int ldb) { return Gemm{K, (unsigned)lda * 2u, 32u, 128u, (unsigned)ldb}; }

__device__ __forceinline__ void tile_of(int L, int nM, int nN, int& pm, int& pn) {
    const int nwg = nM * nN; int wgid = L;
    { const int q = nwg / NXCD, r = nwg % NXCD, xcd = wgid % NXCD, off = wgid / NXCD; wgid = (xcd < r ? xcd * (q + 1) : r * (q + 1) + (xcd - r) * q) + off; }
    const int nig = WGM * nN, gid = wgid / nig, fm = gid * WGM, gsz = (nM - fm) < WGM ? (nM - fm) : WGM;
    pm = fm + ((wgid % nig) % gsz); pn = (wgid % nig) / gsz;
}

typedef int i32x4 __attribute__((ext_vector_type(4)));
typedef int i32x8 __attribute__((ext_vector_type(8)));
template <class Epi, class Sched, bool ALIGN_EPI = true, bool SP2 = true, bool FP8 = false, bool GATHER = false, bool I8 = false>
__device__ __forceinline__ void gemm_phase(PG8_LAS unsigned char* lds, const Gemm g, const Sched& S, Epi& E, const int tid) {
    const int wid = __builtin_amdgcn_readfirstlane(tid >> 6), lane = tid & 63, wr = wid >> 2, wc = wid & 3, fr = lane & 15, fq = lane >> 4;
    const int K = g.K, nt = K / BK;
    unsigned voffA[2], voffB[2]; int rowA[2]; unsigned colA[2];
#pragma unroll
    for (int i = 0; i < 2; ++i) { int R, C; stage_rc(tid * 16 + i * 8192, R, C); const int Rb = Epi::PERM ? ((R & ~31) + perm32(R & 31)) : R;
        rowA[i] = R; colA[i] = (unsigned)(C >> 4) * g.a_grp + (unsigned)(C & 15) * 2u;
        voffA[i] = (unsigned)R * g.a_row + colA[i]; voffB[i] = (unsigned)(Rb * (int)g.ldb + C) * 2u; }
    unsigned vA[2][2], nvA[2][2];
#define PG8_GIDX(dst, unit) do { _Pragma("unroll") for (int _h = 0; _h < 2; ++_h) _Pragma("unroll") for (int _i = 0; _i < 2; ++_i) dst[_h][_i] = (unsigned)(unit).rows[_h * HALF + rowA[_i]] * g.a_row + colA[_i]; } while (0)
#define PG8_STAGE_A(bufoff, gbase, h, nx) do { if constexpr (GATHER) { unsigned _vo[2] = {(nx) ? nvA[h][0] : vA[h][0], (nx) ? nvA[h][1] : vA[h][1]}; PG8_STAGE(bufoff, gbase, _vo); } \
        else { PG8_STAGE(bufoff, (gbase) + (h) * hstepA, voffA); } } while (0)
    constexpr unsigned kstepB = BK * 2; const unsigned kstepA = g.a_kstep;
    const unsigned hstepA = (unsigned)HALF * g.a_row, hstepB = (unsigned)HALF * g.ldb * 2u;
    const unsigned ldsw = (unsigned)wid * 1024u;
    int one_e8m0 = 0x7F7F7F7F; asm volatile("" : "+v"(one_e8m0));
    (void)one_e8m0;
    const unsigned ldsbase = (unsigned)__builtin_amdgcn_readfirstlane((int)(unsigned)(size_t)lds) + ldsw;
    const int aoff = lds_byte(wr * 64 + fr, fq * 8), boff = lds_byte(wc * 32 + fr, fq * 8);
#define PG8_SA(b, h) (((b) * 2 + (h)) * HTB)
#define PG8_SB(b, h) ((4 + (b) * 2 + (h)) * HTB)
#define PG8_STAGE(bufoff, gbase, voff) do { _Pragma("unroll") for (int _i = 0; _i < 2; ++_i) { unsigned _keep; \
        asm volatile("s_mov_b32 %0, m0\n\ts_mov_b32 m0, %1\n\ts_nop 0\n\tglobal_load_lds_dwordx4 %2, %3\n\ts_mov_b32 m0, %0" : "=&s"(_keep) : "s"(ldsbase + (unsigned)((bufoff) + _i * 8192)), "v"((voff)[_i]), "s"((const char*)(gbase)) : "memory"); } } while (0)
#define PG8_CAT(x0, x1) __builtin_shufflevector((x0), (x1), 0, 1, 2, 3, 4, 5, 6, 7)
#define PG8_LDA(dst, b, h) do { _Pragma("unroll") for (int m = 0; m < 4; ++m) { if constexpr (FP8) dst##_8[m] = PG8_CAT(*(const PG8_LAS i32x4*)(lds + PG8_SA(b, h) + aoff + m * 2048), *(const PG8_LAS i32x4*)(lds + PG8_SA(b, h) + aoff + m * 2048 + 1024)); \
        else { _Pragma("unroll") for (int k = 0; k < 2; ++k) dst[m][k] = *(const PG8_LAS bf16x8*)(lds + PG8_SA(b, h) + aoff + m * 2048 + k * 1024); } } } while (0)
#define PG8_LDB(dst, b, h) do { _Pragma("unroll") for (int n = 0; n < 2; ++n) { if constexpr (FP8) dst##_8[n] = PG8_CAT(*(const PG8_LAS i32x4*)(lds + PG8_SB(b, h) + boff + n * 2048), *(const PG8_LAS i32x4*)(lds + PG8_SB(b, h) + boff + n * 2048 + 1024)); \
        else { _Pragma("unroll") for (int k = 0; k < 2; ++k) dst[n][k] = *(const PG8_LAS bf16x8*)(lds + PG8_SB(b, h) + boff + n * 2048 + k * 1024); } } } while (0)
#define PG8_MMA(ai, bj, At, Bt) do { __builtin_amdgcn_s_setprio(1); \
        if constexpr (FP8) { _Pragma("unroll") for (int m = 0; m < 4; ++m) _Pragma("unroll") for (int n = 0; n < 2; ++n) \
            acc[ai][bj][m][n] = __builtin_amdgcn_mfma_scale_f32_16x16x128_f8f6f4(Bt##_8[n], At##_8[m], acc[ai][bj][m][n], 0, 0, 0, one_e8m0, 0, one_e8m0); } \
        else if constexpr (I8) { _Pragma("unroll") for (int m = 0; m < 4; ++m) _Pragma("unroll") for (int n = 0; n < 2; ++n) _Pragma("unroll") for (int k = 0; k < 2; ++k) \
            acc[ai][bj][m][n] = __builtin_bit_cast(f32x4, __builtin_amdgcn_mfma_i32_16x16x64_i8(__builtin_bit_cast(i32x4, Bt[n][k]), __builtin_bit_cast(i32x4, At[m][k]), __builtin_bit_cast(i32x4, acc[ai][bj][m][n]), 0, 0, 0)); } \
        else { _Pragma("unroll") for (int m = 0; m < 4; ++m) _Pragma("unroll") for (int n = 0; n < 2; ++n) _Pragma("unroll") for (int k = 0; k < 2; ++k) \
            acc[ai][bj][m][n] = __builtin_amdgcn_mfma_f32_16x16x32_bf16(Bt[n][k], At[m][k], acc[ai][bj][m][n], 0, 0, 0); } \
        __builtin_amdgcn_s_setprio(0); } while (0)
#define PG8_WAIT_V(n) asm volatile("s_waitcnt vmcnt(" #n ")" ::: "memory")
#define PG8_WAIT_L(n) asm volatile("s_waitcnt lgkmcnt(" #n ")" ::: "memory")
#define PG8_BAR __builtin_amdgcn_s_barrier()
#define PG8_SCHED __builtin_amdgcn_sched_barrier(0)
    Unit cur, nxt; int ui = 0;
    if (!S.next(0, cur)) return;
    f32x4 acc[2][2][4][2];
#pragma unroll
    for (int a = 0; a < 2; ++a)
#pragma unroll
        for (int b = 0; b < 2; ++b)
#pragma unroll
            for (int m = 0; m < 4; ++m)
#pragma unroll
                for (int n = 0; n < 2; ++n) acc[a][b][m][n] = (f32x4){0.f, 0.f, 0.f, 0.f};
    bf16x8 At[4][2], B0[2][2], B1[2][2]; i32x8 At_8[4], B0_8[2], B1_8[2];
    const char* cA = cur.a; const char* cB = cur.b;
    if constexpr (GATHER) { PG8_GIDX(vA, cur); }
    if constexpr (SP2) {
        PG8_STAGE(PG8_SB(0, 0), cB, voffB); PG8_STAGE(PG8_SB(0, 1), cB + hstepB, voffB); PG8_STAGE_A(PG8_SA(0, 0), cA, 0, false); PG8_STAGE_A(PG8_SA(0, 1), cA, 1, false);
        if (wr == 1) PG8_BAR;
        PG8_WAIT_V(2); PG8_BAR;
        PG8_STAGE(PG8_SB(1, 0), cB + kstepB, voffB); PG8_STAGE_A(PG8_SA(1, 0), cA + kstepA, 0, false); PG8_STAGE(PG8_SB(1, 1), cB + hstepB + kstepB, voffB);
        PG8_WAIT_V(6); PG8_BAR;
    } else {
        PG8_STAGE(PG8_SB(0, 0), cB, voffB); PG8_STAGE_A(PG8_SA(0, 0), cA, 0, false); PG8_STAGE(PG8_SB(0, 1), cB + hstepB, voffB); PG8_STAGE_A(PG8_SA(0, 1), cA, 1, false);
        if (wr == 1) PG8_BAR;
        PG8_WAIT_V(4); PG8_BAR;
        PG8_STAGE(PG8_SB(1, 0), cB + kstepB, voffB); PG8_STAGE_A(PG8_SA(1, 0), cA + kstepA, 0, false); PG8_STAGE(PG8_SB(1, 1), cB + hstepB + kstepB, voffB);
        PG8_WAIT_V(6); PG8_BAR;
    }
    for (;;) {
        const bool has_next = S.next(ui + 1, nxt);
        const char* nA = has_next ? nxt.a : cA; const char* nB = has_next ? nxt.b : cB;
        int nidx[2][2];
        if constexpr (GATHER) { if (has_next) { _Pragma("unroll") for (int _h = 0; _h < 2; ++_h) _Pragma("unroll") for (int _i = 0; _i < 2; ++_i)
            asm volatile("global_load_dword %0, %1, %2" : "=v"(nidx[_h][_i]) : "v"((unsigned)(_h * HALF + rowA[_i]) * 4u), "s"(nxt.rows) : "memory"); } }
        int ntu = nt; bool ksk = false;
        if constexpr (Sched::KSKIP) { ksk = S.kskip(cur); if (ksk) ntu = nt - Sched::KS_N; }
        for (int t = 0; t < ntu; t += 2) {
            const bool last = (t == ntu - 2);
            if constexpr (GATHER) { if (last) { if (has_next) { asm volatile("" : "+v"(nidx[0][0]), "+v"(nidx[0][1]), "+v"(nidx[1][0]), "+v"(nidx[1][1]));
                    _Pragma("unroll") for (int _h = 0; _h < 2; ++_h) _Pragma("unroll") for (int _i = 0; _i < 2; ++_i) nvA[_h][_i] = (unsigned)nidx[_h][_i] * g.a_row + colA[_i]; }
                else { _Pragma("unroll") for (int _h = 0; _h < 2; ++_h) { nvA[_h][0] = vA[_h][0]; nvA[_h][1] = vA[_h][1]; } } } }
            int k1 = t + 1, k2 = t + 2;
            if constexpr (Sched::KSKIP) { if (ksk) { if (t >= Sched::KS_LO) k1 += Sched::KS_N; if (t + 2 >= Sched::KS_LO) k2 += Sched::KS_N; } }
            const char* a1 = cA + (unsigned)k1 * kstepA;
            const char* a2 = last ? nA : cA + (unsigned)k2 * kstepA; const char* b2 = last ? nB : cB + (unsigned)k2 * kstepB;
            const char* a3 = a2 + kstepA; const char* b3 = b2 + kstepB;
            if constexpr (SP2) {
            PG8_LDB(B0, 0, 0); if constexpr (!Epi::HALFN) PG8_LDB(B1, 0, 1); PG8_SCHED; PG8_LDA(At, 0, 0); PG8_STAGE_A(PG8_SA(1, 1), a1, 1, false);
            PG8_WAIT_V(8); PG8_WAIT_L(0); PG8_BAR; PG8_MMA(0, 0, At, B0); if constexpr (!Epi::HALFN) PG8_MMA(0, 1, At, B1); PG8_BAR; PG8_SCHED;
            PG8_LDA(At, 0, 1); PG8_STAGE(PG8_SB(0, 0), b2, voffB); PG8_STAGE(PG8_SB(0, 1), b2 + hstepB, voffB); PG8_STAGE_A(PG8_SA(0, 0), a2, 0, last);
            PG8_WAIT_V(8); PG8_WAIT_L(0); PG8_BAR; PG8_MMA(1, 0, At, B0); if constexpr (!Epi::HALFN) PG8_MMA(1, 1, At, B1); PG8_BAR; PG8_SCHED;
            PG8_LDB(B0, 1, 0); if constexpr (!Epi::HALFN) PG8_LDB(B1, 1, 1); PG8_SCHED; PG8_LDA(At, 1, 0); PG8_STAGE_A(PG8_SA(0, 1), a2, 1, last);
            PG8_WAIT_V(8); PG8_WAIT_L(0); PG8_BAR; PG8_MMA(0, 0, At, B0); if constexpr (!Epi::HALFN) PG8_MMA(0, 1, At, B1); PG8_BAR; PG8_SCHED;
            PG8_LDA(At, 1, 1); PG8_STAGE(PG8_SB(1, 0), b3, voffB); PG8_STAGE(PG8_SB(1, 1), b3 + hstepB, voffB); PG8_STAGE_A(PG8_SA(1, 0), a3, 0, last);
            PG8_WAIT_V(8); PG8_WAIT_L(0); PG8_BAR; PG8_MMA(1, 0, At, B0); if constexpr (!Epi::HALFN) PG8_MMA(1, 1, At, B1); PG8_BAR; PG8_SCHED;
            } else {
            PG8_LDB(B0, 0, 0); PG8_SCHED; PG8_LDA(At, 0, 0); PG8_STAGE_A(PG8_SA(1, 1), a1, 1, false);
            PG8_WAIT_L(8); PG8_BAR; PG8_WAIT_L(0); PG8_MMA(0, 0, At, B0); PG8_BAR; PG8_SCHED;
            PG8_LDB(B1, 0, 1); PG8_STAGE(PG8_SB(0, 0), b2, voffB);
            PG8_BAR; PG8_WAIT_L(0); PG8_MMA(0, 1, At, B1); PG8_BAR;
            PG8_LDA(At, 0, 1); PG8_STAGE_A(PG8_SA(0, 0), a2, 0, last);
            PG8_BAR; PG8_WAIT_L(0); PG8_MMA(1, 0, At, B0); PG8_BAR; PG8_SCHED;
            PG8_STAGE(PG8_SB(0, 1), b2 + hstepB, voffB);
            PG8_WAIT_V(6); PG8_BAR; PG8_MMA(1, 1, At, B1); PG8_BAR;
            PG8_LDB(B0, 1, 0); PG8_SCHED; PG8_LDA(At, 1, 0); PG8_STAGE_A(PG8_SA(0, 1), a2, 1, last);
            PG8_WAIT_L(8); PG8_BAR; PG8_WAIT_L(0); PG8_MMA(0, 0, At, B0); PG8_BAR; PG8_SCHED;
            PG8_LDB(B1, 1, 1); PG8_STAGE(PG8_SB(1, 0), b3, voffB);
            PG8_BAR; PG8_WAIT_L(0); PG8_MMA(0, 1, At, B1); PG8_BAR;
            PG8_LDA(At, 1, 1); PG8_STAGE_A(PG8_SA(1, 0), a3, 0, last);
            PG8_BAR; PG8_WAIT_L(0); PG8_MMA(1, 0, At, B0); PG8_BAR; PG8_SCHED;
            PG8_STAGE(PG8_SB(1, 1), b3 + hstepB, voffB);
            PG8_WAIT_V(6); PG8_BAR; PG8_MMA(1, 1, At, B1); PG8_BAR;
            }
        }
        if constexpr (ALIGN_EPI) { if (wr == 0) PG8_BAR; }
        E(acc, cur, wr, wc, fr, fq);
        if (!has_next) break;
#pragma unroll
        for (int a = 0; a < 2; ++a)
#pragma unroll
            for (int b = 0; b < 2; ++b)
#pragma unroll
                for (int m = 0; m < 4; ++m)
#pragma unroll
                    for (int n = 0; n < 2; ++n) acc[a][b][m][n] = (f32x4){0.f, 0.f, 0.f, 0.f};
        cur = nxt; cA = nA; cB = nB; ++ui;
        if constexpr (GATHER) { _Pragma("unroll") for (int _h = 0; _h < 2; ++_h) { vA[_h][0] = nvA[_h][0]; vA[_h][1] = nvA[_h][1]; } }
        if constexpr (ALIGN_EPI) { if (wr == 1) PG8_BAR; }
    }
    PG8_WAIT_V(0);
    if constexpr (!ALIGN_EPI) { if (wr == 0) PG8_BAR; }
    PG8_BAR;
#undef PG8_SA
#undef PG8_SB
#undef PG8_STAGE
#undef PG8_STAGE_A
#undef PG8_GIDX
#undef PG8_LDA
#undef PG8_LDB
#undef PG8_MMA
#undef PG8_CAT
#undef PG8_WAIT_V
#undef PG8_WAIT_L
#undef PG8_BAR
#undef PG8_SCHED
}

struct SchedPlain {
    static constexpr bool KSKIP = false;
    const char* A; const char* B; int nM, nN, G, c; unsigned astep, bstep;
    __device__ __forceinline__ bool next(int i, Unit& u) const { const int L = i * G + c; if (L >= nM * nN) return false; int pm, pn; tile_of(L, nM, nN, pm, pn);
        u.pm = pm; u.pn = pn; u.a = A + (unsigned)pm * astep; u.b = B + (unsigned)pn * bstep; u.rows = nullptr; return true; }
};
template <bool KSK>
struct SchedGroupT {
    static constexpr bool KSKIP = KSK; static constexpr int KS_LO = 4, KS_N = 4;
    const char* A; const char* B; int nM, nN, G, c; unsigned astep, bstep, gstep;
    __device__ __forceinline__ bool next(int i, Unit& u) const { const int L = i * G + c; if (L >= nM * nN) return false; int pm, pn; tile_of(L, nM, nN, pm, pn);
        if (KSK) pn ^= (i & 1);
        u.pm = pm; u.pn = pn; u.a = A + (unsigned)pm * astep; u.b = B + ((unsigned)(pm >> 3) * gstep + (unsigned)pn * bstep); u.rows = nullptr; return true; }
    __device__ __forceinline__ bool kskip(const Unit& u) const { return KSK && u.pn == 0; }
};
typedef SchedGroupT<false> SchedGroup;
typedef SchedGroupT<true> SchedGroupS5;
struct SchedExpert {
    static constexpr bool KSKIP = false;
    const char* A; const char* W; const int* pexp; int p0, nM, nN, G, c; unsigned astep, bstep, estep; int a_local; const int* s2t; int skipc, full_rounds;
    __device__ __forceinline__ bool next(int i, Unit& u) const {
        int L = i * G + c;
        if (skipc > 0 && i >= full_rounds) { if (c < skipc) return false; L = full_rounds * G + (i - full_rounds) * (G - skipc) + (c - skipc); }
        if (L >= nM * nN) return false; int pm, pn; tile_of(L, nM, nN, pm, pn);
        const int e = pexp ? __builtin_amdgcn_readfirstlane(pexp[p0 + pm]) : 0;
        u.pm = p0 + pm; u.pn = pn; u.a = s2t ? A : A + (unsigned)(a_local ? pm : p0 + pm) * astep; u.b = W + ((unsigned)e * estep + (unsigned)pn * bstep); u.rows = s2t ? s2t + (p0 + pm) * 256 : nullptr; return true; }
};

struct EpiInProj {
    static constexpr bool PERM = true; static constexpr bool HALFN = false;
    unsigned char* ws; const float* b_alpha; const float* sa; const float* sw;
    static __device__ __forceinline__ f32x4 dq(const f32x4& a, const float rs, const f32x4& cs) { const i32x4 ai = __builtin_bit_cast(i32x4, a); return (f32x4){(float)ai[0] * (rs * cs[0]), (float)ai[1] * (rs * cs[1]), (float)ai[2] * (rs * cs[2]), (float)ai[3] * (rs * cs[3])}; }
    static __device__ __forceinline__ f32x4 dq1(const f32x4& a, const float c) { const i32x4 ai = __builtin_bit_cast(i32x4, a); return (f32x4){(float)ai[0] * c, (float)ai[1] * c, (float)ai[2] * c, (float)ai[3] * c}; }
    __device__ __forceinline__ void operator()(const f32x4 (&acc)[2][2][4][2], const Unit& u, int wr, int wc, int fr, int fq) const {
        const int pn = u.pn;
        f32x4 cs[2][2]; float rsv[2][4];
#pragma unroll
        for (int bj = 0; bj < 2; ++bj) { const float* p = sw + pn * 256 + bj * HALF + wc * 32 + 8 * fq; cs[bj][0] = *(const f32x4*)p; cs[bj][1] = *(const f32x4*)(p + 4); }
#pragma unroll
        for (int ai = 0; ai < 2; ++ai)
#pragma unroll
            for (int m = 0; m < 4; ++m) rsv[ai][m] = sa[u.pm * BM + ai * HALF + wr * 64 + m * 16 + fr];
        if (pn == 8) {
            bf16* la = (bf16*)(ws + WS_LA);
#pragma unroll
            for (int bj = 0; bj < 2; ++bj) {
                const int cl = bj * HALF + wc * 32 + 8 * fq;
                const f32x4 b0 = *(const f32x4*)(b_alpha + cl), b1 = *(const f32x4*)(b_alpha + cl + 4);
#pragma unroll
                for (int ai = 0; ai < 2; ++ai)
#pragma unroll
                    for (int m = 0; m < 4; ++m) {
                        const int R = u.pm * BM + ai * HALF + wr * 64 + m * 16 + fr;
                        bf16* o = la + (size_t)R * GDK + cl;
                        const float rs = rsv[ai][m]; const f32x4 v0 = dq(acc[ai][bj][m][0], rs, cs[bj][0]), v1 = dq(acc[ai][bj][m][1], rs, cs[bj][1]);
                        f32x4 r0, r1;
#pragma unroll
                        for (int j = 0; j < 4; ++j) { const float x0 = v0[j] + b0[j], x1 = v1[j] + b1[j];
                            r0[j] = (fminf(x0, 0.f) - __logf(1.0f + __expf(-fabsf(x0)))) * (1.0f / 16.0f); r1[j] = (fminf(x1, 0.f) - __logf(1.0f + __expf(-fabsf(x1)))) * (1.0f / 16.0f); }
                        *(v4u*)o = (v4u){pk2(r0[0], r0[1]), pk2(r0[2], r0[3]), pk2(r1[0], r1[1]), pk2(r1[2], r1[3])};
                        asm volatile("" ::: "memory");
                    }
            }
        } else if (pn < 2) {
            bf16* aext = (bf16*)(ws + WS_AEXT);
#pragma unroll
            for (int ai = 0; ai < 2; ++ai)
#pragma unroll
                for (int m = 0; m < 4; ++m) {
                    const int R = u.pm * BM + ai * HALF + wr * 64 + m * 16 + fr, b = R >> 11, t = R & 2047;
                    bf16* rowp = aext + ((size_t)(b * S5NC + (t >> 5)) * S5LDA + (t & 31) * 16); const float rs = rsv[ai][m];
#pragma unroll
                    for (int bj = 0; bj < 2; ++bj) {
                        const int ch = pn * 256 + bj * HALF + wc * 32 + 8 * fq, g = ch >> 4, h8 = ch & 8;
                        const float c = rs * cs[bj][0][0]; const f32x4 v0 = dq1(acc[ai][bj][m][0], c), v1 = dq1(acc[ai][bj][m][1], c);
                        v4u w; w.x = pk2(v0[0], v0[1]); w.y = pk2(v0[2], v0[3]); w.z = pk2(v1[0], v1[1]); w.w = pk2(v1[2], v1[3]);
                        *(v4u*)(rowp + (size_t)g * S5ROWS * S5LDA + h8) = w;
                    }
                    asm volatile("" ::: "memory");
                }
        } else {
            bf16* base; int ldc, c0;
            if (pn == 2) { base = (bf16*)(ws + WS_Q); ldc = GDK; c0 = 0; } else if (pn == 3) { base = (bf16*)(ws + WS_K); ldc = GDK; c0 = 0; }
            else if (pn < 6) { base = (bf16*)(ws + WS_V); ldc = GW; c0 = (pn - 4) * 256; } else { base = (bf16*)(ws + WS_GO); ldc = GW; c0 = (pn - 6) * 256; }
#pragma unroll
            for (int ai = 0; ai < 2; ++ai)
#pragma unroll
                for (int m = 0; m < 4; ++m) { const int R = u.pm * BM + ai * HALF + wr * 64 + m * 16 + fr; bf16* rowp = base + (size_t)R * ldc + c0 + wc * 32 + 8 * fq; const float rs = rsv[ai][m];
#pragma unroll
                    for (int bj = 0; bj < 2; ++bj) { const float c = rs * cs[bj][0][0]; const f32x4 v0 = dq1(acc[ai][bj][m][0], c), v1 = dq1(acc[ai][bj][m][1], c);
                        v4u w; w.x = pk2(v0[0], v0[1]); w.y = pk2(v0[2], v0[3]); w.z = pk2(v1[0], v1[1]); w.w = pk2(v1[2], v1[3]);
                        *(v4u*)(rowp + bj * HALF) = w; }
                    asm volatile("" ::: "memory"); }
        }
    }
};
struct EpiS1 {
    static constexpr bool PERM = true; static constexpr bool HALFN = true;
    bf16* sloc;
    __device__ __forceinline__ void operator()(const f32x4 (&acc)[2][2][4][2], const Unit& u, int wr, int wc, int fr, int fq) const {
#pragma unroll
        for (int ai = 0; ai < 2; ++ai)
#pragma unroll
            for (int m = 0; m < 4; ++m) { bf16* rowp = sloc + (size_t)(u.pm * BM + ai * HALF + wr * 64 + m * 16 + fr) * 128 + wc * 32 + 8 * fq;
                const f32x4 v0 = acc[ai][0][m][0], v1 = acc[ai][0][m][1];
                *(v4u*)rowp = (v4u){pk2(v0[0], v0[1]), pk2(v0[2], v0[3]), pk2(v1[0], v1[1]), pk2(v1[2], v1[3])}; }
    }
};
struct EpiS5 {
    static constexpr bool PERM = true; static constexpr bool HALFN = false;
    const bf16* aext; const float* dskip; bf16* ys5;
    __device__ __forceinline__ void operator()(const f32x4 (&acc)[2][2][4][2], const Unit& u, int wr, int wc, int fr, int fq) const {
        const int g = u.pm >> 3;
#pragma unroll
        for (int bj = 0; bj < 2; ++bj) {
            const int c = u.pn * 256 + bj * HALF + wc * 32 + 8 * fq, h8 = c & 8;
            const f32x4 d0 = *(const f32x4*)(dskip + g * 16 + h8), d1 = *(const f32x4*)(dskip + g * 16 + h8 + 4);
            v4u uv[2][4];
#pragma unroll
            for (int ai = 0; ai < 2; ++ai)
#pragma unroll
                for (int m = 0; m < 4; ++m) uv[ai][m] = *(const v4u*)(aext + (size_t)(u.pm * BM + ai * HALF + wr * 64 + m * 16 + fr) * S5LDA + c);
#pragma unroll
            for (int ai = 0; ai < 2; ++ai)
#pragma unroll
                for (int m = 0; m < 4; ++m) {
                    const int rho = u.pm * BM + ai * HALF + wr * 64 + m * 16 + fr;
                    const v4u uu = uv[ai][m];
                    const f32x4 v0 = acc[ai][bj][m][0], v1 = acc[ai][bj][m][1];
                    float y[8];
                    y[0] = v0[0] + d0[0] * bflo(uu.x); y[1] = v0[1] + d0[1] * bfhi(uu.x); y[2] = v0[2] + d0[2] * bflo(uu.y); y[3] = v0[3] + d0[3] * bfhi(uu.y);
                    y[4] = v1[0] + d1[0] * bflo(uu.z); y[5] = v1[1] + d1[1] * bfhi(uu.z); y[6] = v1[2] + d1[2] * bflo(uu.w); y[7] = v1[3] + d1[3] * bfhi(uu.w);
#pragma unroll
                    for (int j = 0; j < 8; ++j) y[j] = gelu_tanh(y[j]);
                    v4u w; w.x = pk2(y[0], y[1]); w.y = pk2(y[2], y[3]); w.z = pk2(y[4], y[5]); w.w = pk2(y[6], y[7]);
                    *(v4u*)(ys5 + (size_t)rho * S5W + c) = w;
                }
            asm volatile("" ::: "memory");
        }
    }
};
struct EpiGlu {
    static constexpr bool PERM = true; static constexpr bool HALFN = false;
    const bf16* ys5; const float* bglu; bf16* ycat;
    __device__ __forceinline__ void operator()(const f32x4 (&acc)[2][2][4][2], const Unit& u, int wr, int wc, int fr, int fq) const {
#pragma unroll
        for (int bj = 0; bj < 2; ++bj) {
            const int c = u.pn * 256 + bj * HALF + wc * 32 + 8 * fq;
            const f32x4 b0 = *(const f32x4*)(bglu + c), b1 = *(const f32x4*)(bglu + c + 4);
            v4u yv[2][4];
#pragma unroll
            for (int ai = 0; ai < 2; ++ai)
#pragma unroll
                for (int m = 0; m < 4; ++m) yv[ai][m] = *(const v4u*)(ys5 + ((size_t)(c >> 4) * M + (u.pm * BM + ai * HALF + wr * 64 + m * 16 + fr)) * 16 + (c & 15));
#pragma unroll
            for (int ai = 0; ai < 2; ++ai)
#pragma unroll
                for (int m = 0; m < 4; ++m) {
                    const int R = u.pm * BM + ai * HALF + wr * 64 + m * 16 + fr;
                    const v4u yy = yv[ai][m];
                    const f32x4 v0 = acc[ai][bj][m][0], v1 = acc[ai][bj][m][1];
                    v4u w;
                    w.x = pk2(bflo(yy.x) * sigmoidf_(v0[0] + b0[0]), bfhi(yy.x) * sigmoidf_(v0[1] + b0[1]));
                    w.y = pk2(bflo(yy.y) * sigmoidf_(v0[2] + b0[2]), bfhi(yy.y) * sigmoidf_(v0[3] + b0[3]));
                    w.z = pk2(bflo(yy.z) * sigmoidf_(v1[0] + b1[0]), bfhi(yy.z) * sigmoidf_(v1[1] + b1[1]));
                    w.w = pk2(bflo(yy.w) * sigmoidf_(v1[2] + b1[2]), bfhi(yy.w) * sigmoidf_(v1[3] + b1[3]));
                    *(v4u*)(ycat + (size_t)R * D + c) = w;
                }
            asm volatile("" ::: "memory");
        }
    }
};
struct EpiPlain {
    static constexpr bool PERM = true; static constexpr bool HALFN = false;
    bf16* out; int ldc; float scale;
    __device__ __forceinline__ void operator()(const f32x4 (&acc)[2][2][4][2], const Unit& u, int wr, int wc, int fr, int fq) const {
#pragma unroll
        for (int ai = 0; ai < 2; ++ai)
#pragma unroll
            for (int m = 0; m < 4; ++m) { bf16* rowp = out + (size_t)(u.pm * BM + ai * HALF + wr * 64 + m * 16 + fr) * ldc + u.pn * 256 + wc * 32 + 8 * fq;
#pragma unroll
                for (int bj = 0; bj < 2; ++bj) { const f32x4 v0 = acc[ai][bj][m][0] * scale, v1 = acc[ai][bj][m][1] * scale;
                    v4u w; w.x = pk2(v0[0], v0[1]); w.y = pk2(v0[2], v0[3]); w.z = pk2(v1[0], v1[1]); w.w = pk2(v1[2], v1[3]);
                    *(v4u*)(rowp + bj * HALF) = w; } }
    }
};
constexpr float ACT_SCALE = 16.f, WD_SCALE = 256.f;
__device__ __forceinline__ float clamp448(float x) { return __builtin_fminf(__builtin_fmaxf(x, -448.f), 448.f); }
__device__ __forceinline__ unsigned pk4_fp8(float a, float b, float c, float d) { int w = 0; w = __builtin_amdgcn_cvt_pk_fp8_f32(clamp448(a), clamp448(b), w, false); w = __builtin_amdgcn_cvt_pk_fp8_f32(clamp448(c), clamp448(d), w, true); return (unsigned)w; }
struct EpiGateUpI8 {
    static constexpr bool PERM = true; static constexpr bool HALFN = false;
    unsigned char* act; int p0; const float* sa; const int* s2t; const float* swb;
    const int* pexp;
    __device__ __forceinline__ void operator()(const f32x4 (&acc)[2][2][4][2], const Unit& u, int wr, int wc, int fr, int fq) const {
        const int e = pexp ? __builtin_amdgcn_readfirstlane(pexp[u.pm]) : 0;
        const float* sw = swb + (size_t)e * (2 * DFF) + u.pn * 256 + wc * 32 + 8 * fq;
        const float sg = sw[0], su = sw[128] * ACT_SCALE;
        float rsv[2][4];
#pragma unroll
        for (int ai = 0; ai < 2; ++ai)
#pragma unroll
            for (int m = 0; m < 4; ++m) rsv[ai][m] = sa[u.pm * BM + ai * HALF + wr * 64 + m * 16 + fr];
#pragma unroll
        for (int ai = 0; ai < 2; ++ai)
#pragma unroll
            for (int m = 0; m < 4; ++m) { const int rl = ai * HALF + wr * 64 + m * 16 + fr;
                const float rs = rsv[ai][m];
                unsigned char* rowp = act + (size_t)((u.pm - p0) * BM + rl) * DFF + u.pn * 128 + wc * 32 + 8 * fq;
                const i32x4 gi0 = __builtin_bit_cast(i32x4, acc[ai][0][m][0]), gi1 = __builtin_bit_cast(i32x4, acc[ai][0][m][1]), ui0 = __builtin_bit_cast(i32x4, acc[ai][1][m][0]), ui1 = __builtin_bit_cast(i32x4, acc[ai][1][m][1]);
                float g[8], uu[8];
                const float cg = rs * sg, cu = rs * su;
#pragma unroll
                for (int j = 0; j < 4; ++j) { g[j] = (float)gi0[j] * cg; g[4 + j] = (float)gi1[j] * cg; uu[j] = (float)ui0[j] * cu; uu[4 + j] = (float)ui1[j] * cu; }
                v2u w; w.x = pk4_fp8(siluf_(g[0]) * uu[0], siluf_(g[1]) * uu[1], siluf_(g[2]) * uu[2], siluf_(g[3]) * uu[3]);
                w.y = pk4_fp8(siluf_(g[4]) * uu[4], siluf_(g[5]) * uu[5], siluf_(g[6]) * uu[6], siluf_(g[7]) * uu[7]);
                *(v2u*)rowp = w;
                asm volatile("" ::: "memory"); }
    }
};
struct EpiGateUp {
    static constexpr bool PERM = true; static constexpr bool HALFN = false;
    unsigned char* act; int p0;
    __device__ __forceinline__ void operator()(const f32x4 (&acc)[2][2][4][2], const Unit& u, int wr, int wc, int fr, int fq) const {
#pragma unroll
        for (int ai = 0; ai < 2; ++ai)
#pragma unroll
            for (int m = 0; m < 4; ++m) { unsigned char* rowp = act + (size_t)((u.pm - p0) * BM + ai * HALF + wr * 64 + m * 16 + fr) * DFF + u.pn * 128 + wc * 32 + 8 * fq;
                const f32x4 g0 = acc[ai][0][m][0], g1 = acc[ai][0][m][1], u0 = acc[ai][1][m][0] * ACT_SCALE, u1 = acc[ai][1][m][1] * ACT_SCALE;
                v2u w; w.x = pk4_fp8(siluf_(g0[0]) * u0[0], siluf_(g0[1]) * u0[1], siluf_(g0[2]) * u0[2], siluf_(g0[3]) * u0[3]);
                w.y = pk4_fp8(siluf_(g1[0]) * u1[0], siluf_(g1[1]) * u1[1], siluf_(g1[2]) * u1[2], siluf_(g1[3]) * u1[3]);
                *(v2u*)rowp = w; }
    }
};
}

#define XB_TMO      128
#define XB_XCNT(j)  (256  + 64 * (j))
#define XB_XSUB(j)  (1280 + 64 * (j))
#define XB_XGEN(j)  (2304 + 64 * (j))
#define XB_TOP      3328
#define XB_TOPGEN   3392
#define XCD_BAR_WORDS 3456
#define XB_SPIN_CAP (1u << 18)
__device__ __forceinline__ unsigned xb_ld(unsigned* p)              { return __hip_atomic_load(p, __ATOMIC_RELAXED, __HIP_MEMORY_SCOPE_AGENT); }
__device__ __forceinline__ unsigned xb_add(unsigned* p, unsigned v) { return __hip_atomic_fetch_add(p, v, __ATOMIC_RELAXED, __HIP_MEMORY_SCOPE_AGENT); }
__device__ __forceinline__ unsigned xb_xcc_id() { return (unsigned)__builtin_amdgcn_s_getreg((3 << 11) | 20) & 0xFu; }
#define XB_SPIN(cond, bar) do { unsigned _sp = 0; while (cond) { __builtin_amdgcn_s_sleep(1); \
    if ((++_sp & 255u) == 0u) { if (xb_ld(&(bar)[XB_TMO])) break; if (_sp > XB_SPIN_CAP) { atomicAdd(&(bar)[XB_TMO], 1u); break; } } } } while (0)
struct XcdBarrier { unsigned* bar; unsigned x; volatile LAS unsigned* st; };
__device__ __forceinline__ XcdBarrier xcd_barrier_post(unsigned* bar, volatile LAS unsigned* st) {
    XcdBarrier b; b.bar = bar; b.x = xb_xcc_id(); b.st = st;
    if (threadIdx.x == 0) (void)xb_add(&bar[XB_XCNT(b.x)], 1u);
    return b;
}
__device__ __forceinline__ void xcd_barrier_complete(unsigned* bar, unsigned x, unsigned& nloc, unsigned& nx) {
    const unsigned G = gridDim.x * gridDim.y * gridDim.z;
    unsigned sum, cnt, mine, sp = 0u;
    for (;;) {
        sum = 0u; cnt = 0u; mine = 0u;
#pragma unroll
        for (unsigned j = 0; j < 16; ++j) { const unsigned c = xb_ld(&bar[XB_XCNT(j)]); sum += c; cnt += (c > 0u) ? 1u : 0u; mine = (j == x) ? c : mine; }
        if (sum == G) break;
        __builtin_amdgcn_s_sleep(1);
        if ((++sp & 255u) == 0u) { if (xb_ld(&bar[XB_TMO])) break; if (sp > XB_SPIN_CAP) { atomicAdd(&bar[XB_TMO], 1u); break; } }
    }
    nloc = mine > 0u ? mine : 1u; nx = cnt > 0u ? cnt : 1u;
}
__device__ __forceinline__ void xcd_barrier(const XcdBarrier& b) {
    asm volatile("s_waitcnt vmcnt(0)" ::: "memory");
    __syncthreads();
    if (threadIdx.x == 0) {
        unsigned* bar = b.bar;
        __builtin_amdgcn_s_waitcnt(0);
        unsigned nloc = b.st[0], nx = b.st[1];
        if (nloc == 0u) { xcd_barrier_complete(bar, b.x, nloc, nx); b.st[0] = nloc; b.st[1] = nx; }
        const unsigned old = xb_add(&bar[XB_XSUB(b.x)], 1u);
        const unsigned gen = old / nloc;
        if (old + 1u == (gen + 1u) * nloc) {
            __builtin_amdgcn_fence(__ATOMIC_RELEASE, "agent");
            asm volatile("s_waitcnt vmcnt(0)" ::: "memory");
            const unsigned og = xb_add(&bar[XB_TOP], 1u);
            const unsigned tg = og / nx;
            if (og + 1u == (tg + 1u) * nx) xb_add(&bar[XB_TOPGEN], 1u);
            else XB_SPIN(xb_ld(&bar[XB_TOPGEN]) == tg, bar);
            __builtin_amdgcn_fence(__ATOMIC_ACQUIRE, "agent");
            xb_add(&bar[XB_XGEN(b.x)], 1u);
            asm volatile("s_waitcnt vmcnt(0)" ::: "memory");
        } else {
            XB_SPIN(xb_ld(&bar[XB_XGEN(b.x)]) == gen, bar);
            __builtin_amdgcn_fence(__ATOMIC_ACQUIRE, "agent");
            asm volatile("s_waitcnt vmcnt(0)" ::: "memory");
        }
    }
    __syncthreads();
}

__device__ __forceinline__ void sub_barrier(unsigned* cnt, unsigned n, unsigned* bar) {
    asm volatile("s_waitcnt vmcnt(0)" ::: "memory");
    __syncthreads();
    if (threadIdx.x == 0) {
        __builtin_amdgcn_fence(__ATOMIC_RELEASE, "agent");
        asm volatile("s_waitcnt vmcnt(0)" ::: "memory");
        (void)xb_add(cnt, 1u);
        XB_SPIN(xb_ld(cnt) < n, bar);
        __builtin_amdgcn_fence(__ATOMIC_ACQUIRE, "agent");
        asm volatile("s_waitcnt vmcnt(0)" ::: "memory");
    }
    __syncthreads();
}

struct Args { const float* in[31]; float* out; unsigned char* ws; int lo, hi; };
static_assert(sizeof(Args) == 31 * 8 + 8 + 8 + 8, "Args has no padding");
#define CAS __attribute__((address_space(4)))
typedef const CAS Args* ArgP;
__device__ __forceinline__ int opaque_v(int x) { asm volatile("" : "+v"(x)); return x; }
__device__ __forceinline__ int opaque_s(int x) { asm volatile("" : "+s"(x)); return x; }
__device__ __forceinline__ int lane_id_volatile() { int x; asm volatile("v_mbcnt_lo_u32_b32 %0, -1, 0\n\tv_mbcnt_hi_u32_b32 %0, -1, %0" : "=v"(x)); return x; }
__device__ __forceinline__ ArgP argp() { ArgP p = (ArgP)__builtin_amdgcn_kernarg_segment_ptr(); asm volatile("" : "+s"(p)); return p; }
enum { I_X = 0, I_C, I_MODW, I_MODB, I_WIN, I_WOUT, I_LRE, I_LIM, I_LDT, I_BRE, I_BIM, I_CRE, I_CIM, I_SD, I_WGLU, I_BGLU, I_WAUP, I_BALPHA, I_GAIN, I_LNMG, I_LNMB,
       I_FG, I_FU, I_FD, I_RW, I_RB, I_MG, I_MU, I_MD, I_LNFG, I_LNFB };

constexpr int TP_RS = 68;
__device__ __forceinline__ void transpose_item(const float* W, int K, int ldw, bf16* WT, int kb, int n0, int drow0, LAS unsigned char* scr, int lane, float qs = 0.f) {
    const int k0 = 64 * kb;
    const float* src = W + (size_t)k0 * ldw + n0 + lane;
    float v[64];
#pragma unroll
    for (int kk = 0; kk < 64; ++kk) v[kk] = src[(size_t)kk * ldw];
    LAS unsigned* row = (LAS unsigned*)(scr + lane * (TP_RS * 2));
#pragma unroll
    for (int kk = 0; kk < 64; kk += 2) { const float a0 = (qs > 0.f) ? q8emu(v[kk], qs) : v[kk], a1 = (qs > 0.f) ? q8emu(v[kk + 1], qs) : v[kk + 1]; row[kk >> 1] = pk2(a0, a1); }
    LDS_WAIT(); asm volatile("" ::: "memory");
    const int c = lane & 7, r = lane >> 3;
#pragma unroll
    for (int i = 0; i < 8; ++i) { const int n = r + 8 * i; const LAS v2u* p = (const LAS v2u*)(scr + n * (TP_RS * 2) + c * 16); const v2u lo = p[0], hi = p[1];
        *(GAS v4u*)(WT + (size_t)(drow0 + n) * K + k0 + 8 * c) = (v4u){lo.x, lo.y, hi.x, hi.y}; }
    LDS_WAIT(); asm volatile("" ::: "memory");
}
__device__ __forceinline__ void transpose_item_fp8(const float* W, int K, int ldw, unsigned char* WT8, int kb, int n0, int drow0, LAS unsigned char* scr, int lane, float scale) {
    const int k0 = 64 * kb;
    const float* src = W + (size_t)k0 * ldw + n0 + lane;
    float v[64];
#pragma unroll
    for (int kk = 0; kk < 64; ++kk) v[kk] = src[(size_t)kk * ldw];
    LAS unsigned* row = (LAS unsigned*)(scr + lane * 68);
#pragma unroll
    for (int kk = 0; kk < 64; kk += 4) row[kk >> 2] = pg8::pk4_fp8(v[kk] * scale, v[kk + 1] * scale, v[kk + 2] * scale, v[kk + 3] * scale);
    LDS_WAIT(); asm volatile("" ::: "memory");
    const int c = lane & 3, r = lane >> 2;
#pragma unroll
    for (int i = 0; i < 4; ++i) { const int n = r + 16 * i; const LAS unsigned* p = (const LAS unsigned*)(scr + n * 68 + c * 16);
        *(GAS v4u*)(WT8 + (size_t)(drow0 + n) * K + k0 + 16 * c) = (v4u){p[0], p[1], p[2], p[3]}; }
    LDS_WAIT(); asm volatile("" ::: "memory");
}
__device__ __forceinline__ void strip_i8_wg(const float* W, int ldw, unsigned char* WT8, float* sw, int n0, int drow0, LAS unsigned char* lds, int wave, int lane) {
    constexpr int K = D;
    const float* src = W + (size_t)(128 * wave) * ldw + n0 + lane;
    float v[128]; float mx = 0.f;
#pragma unroll
    for (int kk = 0; kk < 128; ++kk) v[kk] = src[(size_t)kk * ldw];
#pragma unroll
    for (int kk = 0; kk < 128; ++kk) mx = __builtin_fmaxf(mx, __builtin_fabsf(v[kk]));
    LAS float* part = (LAS float*)lds;
    part[wave * 64 + lane] = mx;
    __syncthreads();
    float cm = part[lane];
#pragma unroll
    for (int w2 = 1; w2 < 8; ++w2) cm = __builtin_fmaxf(cm, part[w2 * 64 + lane]);
    cm = wave_max_nonneg(cm);
    if (wave == 0) sw[drow0 + lane] = cm * (1.0f / 127.0f);
    const float inv = cm > 0.f ? 127.0f / cm : 0.f;
    LAS unsigned char* scr = lds + 4096 + wave * 8192;
#pragma unroll
    for (int half = 0; half < 2; ++half) {
        LAS unsigned* row = (LAS unsigned*)(scr + lane * 68);
#pragma unroll
        for (int kk = 0; kk < 64; kk += 4) row[kk >> 2] = pk4_i8(v[64 * half + kk] * inv, v[64 * half + kk + 1] * inv, v[64 * half + kk + 2] * inv, v[64 * half + kk + 3] * inv);
        LDS_WAIT(); asm volatile("" ::: "memory");
        const int c = lane & 3, r = lane >> 2, k0 = 128 * wave + 64 * half;
#pragma unroll
        for (int i = 0; i < 4; ++i) { const int n = r + 16 * i; const LAS unsigned* p = (const LAS unsigned*)(scr + n * 68 + c * 16);
            *(GAS v4u*)(WT8 + (size_t)(drow0 + n) * K + k0 + 16 * c) = (v4u){p[0], p[1], p[2], p[3]}; }
        LDS_WAIT(); asm volatile("" ::: "memory");
    }
    __syncthreads();
}
__device__ __forceinline__ void prologue_strips(ArgP a, LAS unsigned char* lds, int wg, int G, int wave, int lane) {
    unsigned char* ws = a->ws;
    constexpr int NS_IN = 2 * 32, NS_GU = 9 * 2 * 56;
    for (int st = wg; st < NS_IN + NS_GU; st += G) {
        if (st < NS_IN) { const int l = st / 32, r = st % 32;
            strip_i8_wg(a->in[I_WIN] + (size_t)l * D * INCOLS, INCOLS, ws + WS_WIN + (size_t)l * NIN * D * 2, (float*)(ws + WS_SWIN) + l * NIN, 64 * r, 64 * r, lds, wave, lane); }
        else { const int q = st - NS_IN, blk = q / 112, r2 = q % 112, up = r2 / 56, r = r2 % 56;
            const float* w = (blk == 0) ? (up ? a->in[I_FU] : a->in[I_FG]) : ((up ? a->in[I_MU] : a->in[I_MG]) + (size_t)(blk - 1) * D * DFF);
            unsigned char* dst = (blk == 0) ? ws + WS_WDEN : ws + WS_WMOE + (size_t)(blk - 1) * WMOE_E;
            strip_i8_wg(w, DFF, dst, (float*)(ws + WS_SW) + (size_t)blk * (2 * DFF), 64 * r, 256 * ((64 * r) >> 7) + ((64 * r) & 127) + 128 * up, lds, wave, lane); }
    }
}
__device__ __forceinline__ int gu_row(int n0, int up) { return 256 * (n0 >> 7) + (n0 & 127) + 128 * up; }

__device__ __forceinline__ void prologue_transposes(ArgP a, LAS unsigned char* lds, int slotA, int slotB, int nslots, int wave, int lane) {
    LAS unsigned char* scr = lds + wave * 16384;
    unsigned char* ws = a->ws;
    constexpr int IT_WOUT = 16 * 16, IT_GLU = 8 * 8, IT_DN = 56 * 16;
    constexpr int NITEMS = 2 * IT_WOUT + 2 * IT_GLU + (1 + NE) * IT_DN;
    struct Desc { const float* src; unsigned char* dst; int ldw, K, k0, n0, fp8; };
    auto item_of = [&](int k) -> int { const int it = (slotB < 0) ? slotA + k * nslots : ((k & 1) ? slotB : slotA) + (k >> 1) * nslots; return it < NITEMS ? it : -1; };
    auto decode = [&](int it, Desc& d) {
        int r = it;
        if (r < 2 * IT_WOUT) { const int l = r / IT_WOUT; r %= IT_WOUT; d.src = a->in[I_WOUT] + (size_t)l * D * D; d.dst = ws + WS_WOUT + (size_t)l * D * D * 2; d.ldw = D; d.K = D; d.k0 = 64 * (r / 16); d.n0 = 64 * (r % 16); d.fp8 = 0; return; }
        r -= 2 * IT_WOUT;
        if (r < 2 * IT_GLU) { const int l = r / IT_GLU; r %= IT_GLU; d.src = a->in[I_WGLU] + (size_t)l * S5W * S5W; d.dst = ws + WS_WGLU + (size_t)l * S5W * S5W * 2; d.ldw = S5W; d.K = S5W; d.k0 = 64 * (r / 8); d.n0 = 64 * (r % 8); d.fp8 = 0; return; }
        r -= 2 * IT_GLU;
        const int blk = r / IT_DN; r %= IT_DN;
        d.src = (blk == 0) ? a->in[I_FD] : a->in[I_MD] + (size_t)(blk - 1) * DFF * D;
        d.dst = ((blk == 0) ? ws + WS_WDEN : ws + WS_WMOE + (size_t)(blk - 1) * WMOE_E) + WMOE_D;
        d.ldw = D; d.K = DFF; d.k0 = 64 * (r / 16); d.n0 = 64 * (r % 16); d.fp8 = 1; };
    auto load = [&](const Desc& d, float (&v)[64]) { const float* src = d.src + (size_t)d.k0 * d.ldw + d.n0 + lane;
#pragma unroll
        for (int kk = 0; kk < 64; ++kk) v[kk] = src[(size_t)kk * d.ldw]; };
    auto store = [&](const Desc& d, float (&v)[64]) {
        if (d.fp8) { LAS unsigned* row = (LAS unsigned*)(scr + lane * 68);
#pragma unroll
            for (int kk = 0; kk < 64; kk += 4) row[kk >> 2] = pg8::pk4_fp8(v[kk] * pg8::WD_SCALE, v[kk + 1] * pg8::WD_SCALE, v[kk + 2] * pg8::WD_SCALE, v[kk + 3] * pg8::WD_SCALE);
            LDS_WAIT(); asm volatile("" ::: "memory");
            const int c = lane & 3, r = lane >> 2;
#pragma unroll
            for (int i = 0; i < 4; ++i) { const int n = r + 16 * i; const LAS unsigned* pq = (const LAS unsigned*)(scr + n * 68 + c * 16);
                *(GAS v4u*)(d.dst + (size_t)(d.n0 + n) * d.K + d.k0 + 16 * c) = (v4u){pq[0], pq[1], pq[2], pq[3]}; }
            LDS_WAIT(); asm volatile("" ::: "memory"); }
        else { LAS unsigned* row = (LAS unsigned*)(scr + lane * (TP_RS * 2));
#pragma unroll
            for (int kk = 0; kk < 64; kk += 2) row[kk >> 1] = pk2(v[kk], v[kk + 1]);
            LDS_WAIT(); asm volatile("" ::: "memory");
            const int c = lane & 7, r = lane >> 3;
#pragma unroll
            for (int i = 0; i < 8; ++i) { const int n = r + 8 * i; const LAS v2u* pq = (const LAS v2u*)(scr + n * (TP_RS * 2) + c * 16); const v2u lo = pq[0], hi = pq[1];
                *(GAS v4u*)((bf16*)d.dst + (size_t)(d.n0 + n) * d.K + d.k0 + 8 * c) = (v4u){lo.x, lo.y, hi.x, hi.y}; }
            LDS_WAIT(); asm volatile("" ::: "memory"); } };
    int it = item_of(0); if (it < 0) return;
    Desc da, db; float va[64], vb[64];
    decode(it, da); load(da, va);
    for (int k = 1;; k += 2) {
        const int i1 = item_of(k);
        if (i1 >= 0) { decode(i1, db); load(db, vb); }
        store(da, va);
        if (i1 < 0) break;
        const int i2 = item_of(k + 1);
        if (i2 >= 0) { decode(i2, da); load(da, va); }
        store(db, vb);
        if (i2 < 0) break;
    }
}

__device__ __forceinline__ void prologue_comb(ArgP a, LAS unsigned char* lds, int wg, int tid) {
    if (wg >= 2 * GDK / 4) return;
    LAS float* part = (LAS float*)lds;
    const int c4 = tid >> 7, k0 = (tid & 127) * 8, col = wg * 4 + c4, l = col / GDK, n = col % GDK;
    const float* win = a->in[I_WIN] + (size_t)l * D * INCOLS + 2048; const float* wup = a->in[I_WAUP] + (size_t)l * GRANK * GDK + n;
    float o[8]; float mx = 0.f;
#pragma unroll
    for (int j = 0; j < 8; ++j) { float sacc = 0.f;
#pragma unroll
        for (int rr = 0; rr < GRANK; ++rr) sacc += win[(size_t)(k0 + j) * INCOLS + rr] * wup[rr * GDK];
        o[j] = sacc; mx = __builtin_fmaxf(mx, __builtin_fabsf(sacc)); }
    { const float wm = wave_max_nonneg(mx); if ((tid & 63) == 0) part[tid >> 6] = wm; }
    __syncthreads();
    const float cm = __builtin_fmaxf(part[2 * c4], part[2 * c4 + 1]), inv = cm > 0.f ? 127.0f / cm : 0.f;
    if ((tid & 127) == 0) ((float*)(a->ws + WS_SWIN))[l * NIN + 2048 + n] = cm * (1.0f / 127.0f);
    v2u w; w.x = pk4_i8(o[0] * inv, o[1] * inv, o[2] * inv, o[3] * inv); w.y = pk4_i8(o[4] * inv, o[5] * inv, o[6] * inv, o[7] * inv);
    *(v2u*)(a->ws + WS_WIN + (size_t)l * NIN * D * 2 + (size_t)(2048 + n) * D + k0) = w;
    __syncthreads();
}

__device__ __forceinline__ void prologue_mod(ArgP a, LAS unsigned char* lds, int wg, int G, int tid) {
    LAS float* cact = (LAS float*)lds;
    LAS float* part = (LAS float*)(lds + 16 * 1024 * 4);
    const float* c = a->in[I_C];
    constexpr int NCB = NMOD * D / 64;
    constexpr int NITEM = 2 * 2 * NCB;
    if (wg < 64) return;
    for (int it = wg - 64; it < NITEM; it += G - 64) {
        const int l = it / (2 * NCB), bh = (it / NCB) & 1, j0 = (it % NCB) * 64;
        for (int i = tid; i < 16 * D; i += 512) { const int b = i >> 10, k = i & 1023; cact[k * 16 + b] = siluf_(c[bh * 16 * D + i]); }
        __syncthreads();
        const int col = tid & 63, ks = tid >> 6;
        const float* w = a->in[I_MODW] + (size_t)l * D * NMOD * D + j0 + col + (size_t)(ks * 128) * NMOD * D;
        f32x4 accv[4];
#pragma unroll
        for (int q = 0; q < 4; ++q) accv[q] = (f32x4){0.f, 0.f, 0.f, 0.f};
        for (int k0 = 0; k0 < 128; k0 += 32) { float wv[32];
#pragma unroll
            for (int kk = 0; kk < 32; ++kk) wv[kk] = w[(size_t)(k0 + kk) * NMOD * D];
#pragma unroll
            for (int kk = 0; kk < 32; ++kk) { const LAS f32x4* cp = (const LAS f32x4*)(cact + (ks * 128 + k0 + kk) * 16);
#pragma unroll
                for (int q = 0; q < 4; ++q) accv[q] += cp[q] * wv[kk]; } }
#pragma unroll
        for (int q = 0; q < 4; ++q) *(LAS f32x4*)(part + (ks * 64 + col) * 16 + 4 * q) = accv[q];
        __syncthreads();
        for (int o = tid; o < 64 * 16; o += 512) { const int cc = o & 63, b = o >> 6; float s = a->in[I_MODB][l * NMOD * D + j0 + cc];
#pragma unroll
            for (int q = 0; q < 8; ++q) s += part[(q * 64 + cc) * 16 + b];
            ((float*)(a->ws + WS_MOD))[((size_t)l * BATCH + bh * 16 + b) * NMOD * D + j0 + cc] = s; }
        __syncthreads();
    }
}
__device__ __forceinline__ void prologue_s5(ArgP a, LAS unsigned char* lds, int lg, int tid) {
    const int l = lg >> 5, g = lg & 31;
    LAS float* pwr = (LAS float*)lds;
    LAS float* pwi = pwr + 64 * 33;
    LAS float* bbr = pwi + 64 * 33;
    LAS float* bbi = bbr + 64 * 16;
    LAS float* ccr = bbi + 64 * 16;
    LAS float* cci = ccr + 16 * 64;
    LAS float* kt = cci + 16 * 64;
    LAS double* f1 = (LAS double*)(kt + 32 * 256);
    const float* lre = a->in[I_LRE] + (size_t)(l * S5G + g) * S5P; const float* lim = a->in[I_LIM] + (size_t)(l * S5G + g) * S5P;
    const double dt = exp((double)a->in[I_LDT][l * S5G + g]);
    const float* bre = a->in[I_BRE] + (size_t)(l * S5G + g) * S5P * S5H; const float* bim = a->in[I_BIM] + (size_t)(l * S5G + g) * S5P * S5H;
    const float* cre = a->in[I_CRE] + (size_t)(l * S5G + g) * S5H * S5P; const float* cim = a->in[I_CIM] + (size_t)(l * S5G + g) * S5H * S5P;
    for (int i = tid; i < 64 * 33; i += 512) { const int p = i / 33, tau = i % 33; const double ar = (double)lre[p] * dt * tau, ai = (double)lim[p] * dt * tau, e = exp(ar), cr = e * cos(ai), ci = e * sin(ai);
        pwr[i] = (float)cr; pwi[i] = (float)ci;
        if (tau == 1) { const double lr = lre[p], li = lim[p], nr = cr - 1.0, den = lr * lr + li * li; f1[2 * p] = (nr * lr + ci * li) / den; f1[2 * p + 1] = (ci * lr - nr * li) / den; } }
    for (int i = tid; i < 16 * 64; i += 512) { ccr[i] = cre[i]; cci[i] = cim[i]; }
    __syncthreads();
    for (int i = tid; i < 64 * 16; i += 512) { const int p = i >> 4; const double fr_ = f1[2 * p], fi_ = f1[2 * p + 1], br = bre[i], bi = bim[i]; bbr[i] = (float)(fr_ * br - fi_ * bi); bbi[i] = (float)(fr_ * bi + fi_ * br); }
    if (tid < 64) { float* lt = (float*)(a->ws + WS_LAMT) + ((size_t)(l * S5G + g) * S5P + tid) * 2; lt[0] = pwr[tid * 33 + 32]; lt[1] = pwi[tid * 33 + 32]; }
    __syncthreads();
    { const int tau = tid >> 4, hp = tid & 15;
      f32x4 acc4[4];
#pragma unroll
      for (int q = 0; q < 4; ++q) acc4[q] = (f32x4){0.f, 0.f, 0.f, 0.f};
      for (int p = 0; p < 64; ++p) { const float cr = ccr[hp * 64 + p], ci = cci[hp * 64 + p], wr_ = pwr[p * 33 + tau], wi_ = pwi[p * 33 + tau];
          const float tr = cr * wr_ - ci * wi_, ti = cr * wi_ + ci * wr_;
#pragma unroll
          for (int q = 0; q < 4; ++q) acc4[q] += *(const LAS f32x4*)(bbr + p * 16 + 4 * q) * tr - *(const LAS f32x4*)(bbi + p * 16 + 4 * q) * ti; }
#pragma unroll
      for (int q = 0; q < 4; ++q) *(LAS f32x4*)(kt + (tau * 16 + hp) * 16 + 4 * q) = acc4[q]; }
    __syncthreads();
    bf16* toep = (bf16*)(a->ws + WS_TOEP) + (size_t)(l * S5G + g) * S5KU * S5LDA;
    for (int i = tid; i < S5KU * (S5LDA / 8); i += 512) { const int row = i / (S5LDA / 8), c0 = (i % (S5LDA / 8)) * 8, ii = row >> 4, hp = row & 15; float o[8];
#pragma unroll
        for (int j = 0; j < 8; ++j) { const int col = c0 + j; float v;
            if (col < S5KU) { const int jj = col >> 4, h = col & 15; v = (jj <= ii) ? kt[((ii - jj) * 16 + hp) * 16 + h] : 0.f; }
            else { const int p = (col - S5KU) & 63; const float cr = ccr[hp * 64 + p], ci = cci[hp * 64 + p], wr_ = pwr[p * 33 + ii + 1], wi_ = pwi[p * 33 + ii + 1];
                v = (col < S5KU + 64) ? (cr * wr_ - ci * wi_) : -(cr * wi_ + ci * wr_); }
            o[j] = v; }
        v4u w; w.x = pk2(o[0], o[1]); w.y = pk2(o[2], o[3]); w.z = pk2(o[4], o[5]); w.w = pk2(o[6], o[7]);
        *(v4u*)(toep + (size_t)row * S5LDA + c0) = w; }
    bf16* ctrl = (bf16*)(a->ws + WS_CTRL) + (size_t)(l * S5G + g) * 256 * S5KU;
    for (int i = tid; i < 256 * (S5KU / 8); i += 512) { const int row = i / (S5KU / 8), c0 = (i % (S5KU / 8)) * 8; float o[8];
#pragma unroll
        for (int j = 0; j < 8; ++j) { const int col = c0 + j, jj = col >> 4, h = col & 15; float v = 0.f;
            if (row < 128) { const int p = row & 63; const float wr_ = pwr[p * 33 + 31 - jj], wi_ = pwi[p * 33 + 31 - jj], br = bbr[p * 16 + h], bi = bbi[p * 16 + h];
                v = (row < 64) ? (wr_ * br - wi_ * bi) : (wr_ * bi + wi_ * br); }
            o[j] = v; }
        v4u w; w.x = pk2(o[0], o[1]); w.y = pk2(o[2], o[3]); w.z = pk2(o[4], o[5]); w.w = pk2(o[6], o[7]);
        *(v4u*)(ctrl + (size_t)row * S5KU + c0) = w; }
    __syncthreads();
}

__device__ __forceinline__ f32x4 carrier4(unsigned qd, unsigned rd, float s, float s254, float c0) {
    const unsigned qu = qd ^ 0x80808080u;
    f32x4 h;
    h.x = __builtin_fmaf((float)((rd >> 0) & 255u), s254, __builtin_fmaf((float)((qu >> 0) & 255u), s, c0));
    h.y = __builtin_fmaf((float)((rd >> 8) & 255u), s254, __builtin_fmaf((float)((qu >> 8) & 255u), s, c0));
    h.z = __builtin_fmaf((float)((rd >> 16) & 255u), s254, __builtin_fmaf((float)((qu >> 16) & 255u), s, c0));
    h.w = __builtin_fmaf((float)((rd >> 24) & 255u), s254, __builtin_fmaf((float)((qu >> 24) & 255u), s, c0));
    return h; }
__device__ __forceinline__ void carrier_q4(f32x4 hq  , unsigned& qd, unsigned& rd) {
    const f32x4 qf = {__builtin_rintf(hq.x), __builtin_rintf(hq.y), __builtin_rintf(hq.z), __builtin_rintf(hq.w)};
    qd = ((unsigned)(int)qf.x & 0xffu) | (((unsigned)(int)qf.y & 0xffu) << 8) | (((unsigned)(int)qf.z & 0xffu) << 16) | ((unsigned)(int)qf.w << 24);
    const f32x4 rr = (hq - qf) * 254.0f + 128.5f;
    unsigned r = 0u;
    r = __builtin_amdgcn_cvt_pk_u8_f32(rr.x, 0, r); r = __builtin_amdgcn_cvt_pk_u8_f32(rr.y, 1, r); r = __builtin_amdgcn_cvt_pk_u8_f32(rr.z, 2, r); r = __builtin_amdgcn_cvt_pk_u8_f32(rr.w, 3, r);
    rd = r; }
__device__ __forceinline__ float rdlane_f(float v, int r) { return __builtin_bit_cast(float, __builtin_amdgcn_readlane(__builtin_bit_cast(int, v), r)); }
__device__ __forceinline__ int rdlane_i(int v, int r) { return __builtin_amdgcn_readlane(v, r); }
#ifndef ROW_INTERLEAVE
#define ROW_INTERLEAVE 1
#endif
#if ROW_INTERLEAVE
#define ROW_OF(rr_) (wg * 256 + (rr_) * 8 + wave)
#else
#define ROW_OF(rr_) (wg * 256 + wave * 32 + (rr_))
#endif
#define ROW0_LANDED4(v_) asm volatile("" :: "v"((v_)[0]), "v"((v_)[1]), "v"((v_)[2]), "v"((v_)[3]))
#define ROW0_LANDED2(v_) asm volatile("" :: "v"((v_)[0]), "v"((v_)[1]))
__device__ __forceinline__ void hmod_rows(const float* x, const float* mod  , int sh_off, int sc_off, bf16* hmod, unsigned char* ws, int wg, int wave, int lane) {
    const float* mb = mod + (size_t)(wg >> 3) * NMOD * D;
    f32x4 pSc[4], pSh[4];
#pragma unroll
    for (int jj = 0; jj < 4; ++jj) { const int o = 8 * lane + 512 * (jj >> 1) + 4 * (jj & 1); pSc[jj] = *(const f32x4*)(mb + sc_off + o) + 1.0f; pSh[jj] = *(const f32x4*)(mb + sh_off + o); }
    f32x4 ax[4], bx[4];
#define HM_LOAD(X_, rr_) do { const GAS f32x4* xr_ = (const GAS f32x4*)(x + (size_t)ROW_OF(rr_) * D) + 2 * lane; _Pragma("unroll") for (int jj = 0; jj < 4; ++jj) X_[jj] = xr_[128 * (jj >> 1) + (jj & 1)]; } while (0)
    HM_LOAD(ax, 0); HM_LOAD(bx, 1);
    ROW0_LANDED4(pSc); ROW0_LANDED4(pSh); ROW0_LANDED4(ax); ROW0_LANDED4(bx);
    float sa_keep = 0.f;
    auto one_row = [&](f32x4 (&X)[4], const int rr, const bool reload) __attribute__((always_inline)) { const int m = ROW_OF(rr);
        f32x4 hv[4]; float hmax = 0.f;
#pragma unroll
        for (int jj = 0; jj < 4; ++jj) hv[jj] = X[jj] * pSc[jj] + pSh[jj];
        if (reload) HM_LOAD(X, rr + 2);
#pragma unroll
        for (int jj = 0; jj < 4; ++jj) hmax = __builtin_fmaxf(hmax, __builtin_fmaxf(__builtin_fmaxf(__builtin_fabsf(hv[jj].x), __builtin_fabsf(hv[jj].y)), __builtin_fmaxf(__builtin_fabsf(hv[jj].z), __builtin_fabsf(hv[jj].w))));
        const float rmax = wave_max_nonneg(hmax), qs = rmax > 0.f ? 127.0f / rmax : 0.f;
        GAS v2u* h8 = (GAS v2u*)(ws + WS_H8 + (size_t)m * D) + lane;
#pragma unroll
        for (int j = 0; j < 2; ++j) { v2u w; w.x = pk4_i8(hv[2 * j].x * qs, hv[2 * j].y * qs, hv[2 * j].z * qs, hv[2 * j].w * qs); w.y = pk4_i8(hv[2 * j + 1].x * qs, hv[2 * j + 1].y * qs, hv[2 * j + 1].z * qs, hv[2 * j + 1].w * qs); h8[64 * j] = w; }
        sa_keep = (lane == rr) ? rmax * (1.0f / 127.0f) : sa_keep; };
    for (int rr = 0; rr < 30; rr += 2) { one_row(ax, rr, true); one_row(bx, rr + 1, true); }
    one_row(ax, 30, false); one_row(bx, 31, false);
#undef HM_LOAD
    if (lane < 32) ((float*)(ws + WS_SA))[ROW_OF(lane)] = sa_keep;
}

constexpr int GL_RS = 72;
constexpr int G2_QT = 0, G2_KT = 64 * GL_RS * 2, G2_KDT = 2 * 64 * GL_RS * 2, G2_VT = 3 * 64 * GL_RS * 2, G2_SET = (3 * 64 + 128) * GL_RS * 2;
constexpr int G2_ST = 2 * G2_SET, G2_P = G2_ST + 128 * GL_RS * 2, G2_DV = G2_P + 4 * 16 * GL_RS * 2, G2_PART = G2_DV + 2 * 64 * 4, G2_END = G2_PART + 64 * 4 * 4;
static_assert(G2_END <= RING_BYTES, "gla lds");
__device__ __forceinline__ bf16x8 lds_frag(const LAS unsigned char* base, int row, int kq) { return *(const LAS bf16x8*)(base + (row * GL_RS + kq * 8) * 2); }
#define GLA_BAR() do { asm volatile("s_waitcnt lgkmcnt(0)" ::: "memory"); __builtin_amdgcn_s_barrier(); asm volatile("" ::: "memory"); } while (0)
__device__ __forceinline__ void gla_phase(ArgP a, int l, LAS unsigned char* lds, int wg, int tid) {
    if (wg >= BATCH * GNH) return;
    constexpr int NC = SEQ / GCH;
    const int b = wg >> 2, h = wg & 3, lane = tid & 63, w = __builtin_amdgcn_readfirstlane(tid >> 6), fr = lane & 15, fq = lane >> 4;
    for (int i = tid; i < 128 * GL_RS / 2; i += 512) ((LAS unsigned*)(lds + G2_ST))[i] = 0u;
    if (w < 4) {
        const int p = w;
        const bf16* lag = (const bf16*)(a->ws + WS_LA) + (size_t)b * SEQ * GDK + h * GHK + 16 * p;
        const bf16* qg = (const bf16*)(a->ws + WS_Q) + (size_t)b * SEQ * GDK + h * GHK + 16 * p;
        const bf16* kg = (const bf16*)(a->ws + WS_K) + (size_t)b * SEQ * GDK + h * GHK + 16 * p;
        const bf16* vg = (const bf16*)(a->ws + WS_V) + (size_t)b * SEQ * GW + h * GHV + 32 * p;
        v4u rla[2]; v4u rq[2], rk[2], rv[4];
#define GLP_LOAD(cc) do { const size_t ro = (size_t)((cc) * GCH + lane) * GDK; const size_t rov = (size_t)((cc) * GCH + lane) * GW; \
            rla[0] = *(const v4u*)(lag + ro); rla[1] = *(const v4u*)(lag + ro + 8); \
            rq[0] = *(const v4u*)(qg + ro); rq[1] = *(const v4u*)(qg + ro + 8); rk[0] = *(const v4u*)(kg + ro); rk[1] = *(const v4u*)(kg + ro + 8); \
            _Pragma("unroll") for (int j = 0; j < 4; ++j) rv[j] = *(const v4u*)(vg + rov + 8 * j); } while (0)
#define GLP_PREP(setoff) do { LAS unsigned char* S_ = lds + (setoff); \
            float bb[16]; \
            _Pragma("unroll") for (int j = 0; j < 16; ++j) { const unsigned lw_ = rla[j >> 3][(j >> 1) & 3]; float x = (j & 1) ? bfhi(lw_) : bflo(lw_); \
                x += DPP_F(x, 0x111, 0xF); x += DPP_F(x, 0x112, 0xF); x += DPP_F(x, 0x114, 0xF); x += DPP_F(x, 0x118, 0xF);     \
                x += DPP_F(x, 0x142, 0xA); x += DPP_F(x, 0x143, 0xC); bb[j] = x; }                                              \
            const unsigned qw[8] = {rq[0].x, rq[0].y, rq[0].z, rq[0].w, rq[1].x, rq[1].y, rq[1].z, rq[1].w}; \
            const unsigned kw[8] = {rk[0].x, rk[0].y, rk[0].z, rk[0].w, rk[1].x, rk[1].y, rk[1].z, rk[1].w}; \
            unsigned qo[8], ko[8]; float dl[16]; \
            _Pragma("unroll") for (int j2 = 0; j2 < 8; ++j2) { \
                const float bl0 = __builtin_bit_cast(float, __builtin_amdgcn_readlane(__builtin_bit_cast(int, bb[2 * j2]), 63)), bl1 = __builtin_bit_cast(float, __builtin_amdgcn_readlane(__builtin_bit_cast(int, bb[2 * j2 + 1]), 63)); \
                const float E0 = __expf(bl0), E1 = __expf(bl1); dl[2 * j2] = E0; dl[2 * j2 + 1] = E1; \
                const float e0 = __expf(bb[2 * j2]), e1 = __expf(bb[2 * j2 + 1]), r0 = frcp(e0), r1 = frcp(e1); \
                const float q0 = bflo(qw[j2]), q1 = bfhi(qw[j2]), k0 = bflo(kw[j2]), k1 = bfhi(kw[j2]); \
                qo[j2] = pk2(q0 * 0.125f * e0, q1 * 0.125f * e1); const float kt0 = k0 * r0, kt1 = k1 * r1; ko[j2] = pk2(kt0, kt1); \
                ((LAS bf16*)(S_ + G2_KDT))[(16 * p + 2 * j2) * GL_RS + lane] = (bf16)f2bf(kt0 * E0); ((LAS bf16*)(S_ + G2_KDT))[(16 * p + 2 * j2 + 1) * GL_RS + lane] = (bf16)f2bf(kt1 * E1); } \
            *(LAS v4u*)(S_ + G2_QT + (lane * GL_RS + 16 * p) * 2) = (v4u){qo[0], qo[1], qo[2], qo[3]}; *(LAS v4u*)(S_ + G2_QT + (lane * GL_RS + 16 * p + 8) * 2) = (v4u){qo[4], qo[5], qo[6], qo[7]}; \
            *(LAS v4u*)(S_ + G2_KT + (lane * GL_RS + 16 * p) * 2) = (v4u){ko[0], ko[1], ko[2], ko[3]}; *(LAS v4u*)(S_ + G2_KT + (lane * GL_RS + 16 * p + 8) * 2) = (v4u){ko[4], ko[5], ko[6], ko[7]}; \
            if (lane == 0) { LAS float* dv_ = (LAS float*)(lds + G2_DV) + ((setoff) ? 64 : 0) + 16 * p; \
                _Pragma("unroll") for (int j = 0; j < 4; ++j) *(LAS f32x4*)(dv_ + 4 * j) = (f32x4){dl[4 * j], dl[4 * j + 1], dl[4 * j + 2], dl[4 * j + 3]}; } \
            const unsigned vw[16] = {rv[0].x, rv[0].y, rv[0].z, rv[0].w, rv[1].x, rv[1].y, rv[1].z, rv[1].w, rv[2].x, rv[2].y, rv[2].z, rv[2].w, rv[3].x, rv[3].y, rv[3].z, rv[3].w}; \
            _Pragma("unroll") for (int j = 0; j < 16; ++j) { ((LAS bf16*)(S_ + G2_VT))[(32 * p + 2 * j) * GL_RS + lane] = (bf16)(vw[j] & 0xffffu); ((LAS bf16*)(S_ + G2_VT))[(32 * p + 2 * j + 1) * GL_RS + lane] = (bf16)(vw[j] >> 16); } \
        } while (0)
        GLP_LOAD(0);
        GLP_PREP(0);
        GLP_LOAD(1);
        GLA_BAR();
        for (int c = 0; c < NC; ++c) {
            if (c + 1 < NC) for (int pr_ = 0; pr_ < GLA_PROD_REPS; ++pr_) { if ((c + 1) & 1) GLP_PREP(G2_SET); else GLP_PREP(0); }
            if (c + 2 < NC) GLP_LOAD(c + 2);
            GLA_BAR();
            GLA_BAR();
        }
#undef GLP_LOAD
#undef GLP_PREP
    } else {
        const int cw = w - 4;
        const bf16* gg = (const bf16*)(a->ws + WS_GO) + (size_t)b * SEQ * GW + h * GHV + 32 * cw;
        bf16* yo = (bf16*)(a->ws + WS_YCAT) + (size_t)b * SEQ * D + S5W + h * GHV + 32 * cw;
        const float* gain = a->in[I_GAIN] + l * GW + h * GHV + 32 * cw;
        float gn[2][4];
#pragma unroll
        for (int vt = 0; vt < 2; ++vt)
#pragma unroll
            for (int r = 0; r < 4; ++r) gn[vt][r] = gain[16 * vt + 4 * fq + r];
        LAS unsigned char* STp = lds + G2_ST; LAS unsigned char* Pp = lds + G2_P + cw * (16 * GL_RS * 2); LAS float* PART = (LAS float*)(lds + G2_PART);
        f32x4 accS[4][2];
#pragma unroll
        for (int kt = 0; kt < 4; ++kt) { accS[kt][0] = (f32x4){0.f, 0.f, 0.f, 0.f}; accS[kt][1] = (f32x4){0.f, 0.f, 0.f, 0.f}; }
        v4u ng[2][2];
#define GLC_LOADG(cc) do { _Pragma("unroll") for (int k2 = 0; k2 < 2; ++k2) _Pragma("unroll") for (int vt = 0; vt < 2; ++vt) \
            ng[k2][vt] = *(const v4u*)(gg + (size_t)((cc) * GCH + 16 * (2 * k2 + (fq & 1)) + fr) * GW + 16 * vt + 4 * (fq & 2)); } while (0)
        GLC_LOADG(0);
        GLA_BAR();
        for (int c = 0; c < NC; ++c) {
            const int t0 = c * GCH;
            const LAS unsigned char* S_ = lds + ((c & 1) ? G2_SET : 0);
            v2u gv[4][2];
#pragma unroll
            for (int k2 = 0; k2 < 2; ++k2)
#pragma unroll
                for (int vt = 0; vt < 2; ++vt) { const v4u w_ = ng[k2][vt];
                    const auto sx_ = __builtin_amdgcn_permlane16_swap(w_.x, w_.z, false, false), sy_ = __builtin_amdgcn_permlane16_swap(w_.y, w_.w, false, false);
                    gv[2 * k2][vt] = (v2u){sx_[0], sy_[0]}; gv[2 * k2 + 1][vt] = (v2u){sx_[1], sy_[1]}; }
            if (c + 1 < NC) GLC_LOADG(c + 1);
            bf16x8 sa[2][2], va[2][2], ka[4][2];
#pragma unroll
            for (int vt = 0; vt < 2; ++vt) { sa[vt][0] = lds_frag(STp, 32 * cw + 16 * vt + fr, fq); sa[vt][1] = lds_frag(STp, 32 * cw + 16 * vt + fr, 4 + fq);
                va[vt][0] = lds_frag(S_ + G2_VT, 32 * cw + 16 * vt + fr, fq); va[vt][1] = lds_frag(S_ + G2_VT, 32 * cw + 16 * vt + fr, 4 + fq); }
#pragma unroll
            for (int jt = 0; jt < 4; ++jt) { ka[jt][0] = lds_frag(S_ + G2_KT, 16 * jt + fr, fq); ka[jt][1] = lds_frag(S_ + G2_KT, 16 * jt + fr, 4 + fq); }
            f32x4 o[4][2]; float ssq[4];
#pragma unroll
            for (int it = 0; it < 4; ++it) {
                const bf16x8 qa0 = lds_frag(S_ + G2_QT, 16 * it + fr, fq), qa1 = lds_frag(S_ + G2_QT, 16 * it + fr, 4 + fq);
#pragma unroll
                for (int jt = 0; jt < 4; ++jt) { if (jt > (it | 1)) continue;
                    v2u pw = (v2u){0u, 0u};
                    if (jt <= it) { f32x4 sc = (f32x4){0.f, 0.f, 0.f, 0.f};
                        sc = __builtin_amdgcn_mfma_f32_16x16x32_bf16(ka[jt][0], qa0, sc, 0, 0, 0); sc = __builtin_amdgcn_mfma_f32_16x16x32_bf16(ka[jt][1], qa1, sc, 0, 0, 0);
                        if (jt == it) { const int d0 = 4 * fq - fr;
                            sc[0] = (d0 + 0 <= 0) ? sc[0] : 0.f; sc[1] = (d0 + 1 <= 0) ? sc[1] : 0.f; sc[2] = (d0 + 2 <= 0) ? sc[2] : 0.f; sc[3] = (d0 + 3 <= 0) ? sc[3] : 0.f; }
                        pw.x = pk2(sc[0], sc[1]); pw.y = pk2(sc[2], sc[3]); }
                    *(LAS v2u*)(Pp + (fr * GL_RS + 16 * jt + 4 * fq) * 2) = pw; }
                asm volatile("s_waitcnt lgkmcnt(0)" ::: "memory");
                const bf16x8 pa0 = lds_frag(Pp, fr, fq), pa1 = lds_frag(Pp, fr, 4 + fq);
                float ss = 0.f;
#pragma unroll
                for (int vt = 0; vt < 2; ++vt) { f32x4 acc = (f32x4){0.f, 0.f, 0.f, 0.f};
                    acc = __builtin_amdgcn_mfma_f32_16x16x32_bf16(sa[vt][0], qa0, acc, 0, 0, 0); acc = __builtin_amdgcn_mfma_f32_16x16x32_bf16(sa[vt][1], qa1, acc, 0, 0, 0);
                    acc = __builtin_amdgcn_mfma_f32_16x16x32_bf16(va[vt][0], pa0, acc, 0, 0, 0); if (it >= 2) acc = __builtin_amdgcn_mfma_f32_16x16x32_bf16(va[vt][1], pa1, acc, 0, 0, 0);
                    o[it][vt] = acc; ss += (acc[0] * acc[0] + acc[1] * acc[1]) + (acc[2] * acc[2] + acc[3] * acc[3]); }
                asm volatile("" ::: "memory");
                ssq[it] = ss;
            }
{
              float s0_ = ssq[0], s1_ = ssq[1], s2_ = ssq[2], s3_ = ssq[3];
              asm volatile("s_nop 1\n\tv_permlane32_swap_b32 %0, %1" : "+v"(s0_), "+v"(s1_));
              asm volatile("s_nop 1\n\tv_permlane32_swap_b32 %0, %1" : "+v"(s2_), "+v"(s3_));
              float u_ = s0_ + s1_, w_ = s2_ + s3_;
              asm volatile("s_nop 1\n\tv_permlane16_swap_b32 %0, %1" : "+v"(u_), "+v"(w_));
              PART[(16 * (((fq & 1) << 1) | (fq >> 1)) + fr) * 4 + cw] = u_ + w_; }
            { const LAS float* DVp = (const LAS float*)(lds + G2_DV) + ((c & 1) ? 64 : 0);
#pragma unroll
              for (int kt = 0; kt < 4; ++kt) { const f32x4 dv = *(const LAS f32x4*)(DVp + 16 * kt + 4 * fq);
                  const bf16x8 kd0 = lds_frag(S_ + G2_KDT, 16 * kt + fr, fq), kd1 = lds_frag(S_ + G2_KDT, 16 * kt + fr, 4 + fq);
#pragma unroll
                  for (int vt = 0; vt < 2; ++vt) { f32x4 sv = accS[kt][vt] * dv;
                      sv = __builtin_amdgcn_mfma_f32_16x16x32_bf16(kd0, va[vt][0], sv, 0, 0, 0); sv = __builtin_amdgcn_mfma_f32_16x16x32_bf16(kd1, va[vt][1], sv, 0, 0, 0);
                      accS[kt][vt] = sv;
                      v2u sw; sw.x = pk2(sv[0], sv[1]); sw.y = pk2(sv[2], sv[3]); *(LAS v2u*)(STp + ((32 * cw + 16 * vt + fr) * GL_RS + 16 * kt + 4 * fq) * 2) = sw; } } }
            GLA_BAR();
#pragma unroll
            for (int k2 = 0; k2 < 2; ++k2) { v2u ow[2][2];
#pragma unroll
                for (int q2 = 0; q2 < 2; ++q2) { const int it = 2 * k2 + q2, i = 16 * it + fr; const f32x4 pp = *(const LAS f32x4*)(PART + i * 4);
                    const float rs = frsq(((pp[0] + pp[1]) + (pp[2] + pp[3])) * (1.0f / 128.0f) + RMS_EPS);
#pragma unroll
                    for (int vt = 0; vt < 2; ++vt) { const float g0 = bflo(gv[it][vt].x), g1 = bfhi(gv[it][vt].x), g2 = bflo(gv[it][vt].y), g3 = bfhi(gv[it][vt].y);
                        ow[q2][vt].x = pk2(o[it][vt][0] * rs * gn[vt][0] * siluf_(g0), o[it][vt][1] * rs * gn[vt][1] * siluf_(g1)); ow[q2][vt].y = pk2(o[it][vt][2] * rs * gn[vt][2] * siluf_(g2), o[it][vt][3] * rs * gn[vt][3] * siluf_(g3)); } }
#pragma unroll
                for (int vt = 0; vt < 2; ++vt) { const auto sx_ = __builtin_amdgcn_permlane16_swap(ow[0][vt].x, ow[1][vt].x, false, false), sy_ = __builtin_amdgcn_permlane16_swap(ow[0][vt].y, ow[1][vt].y, false, false);
                    *(v4u*)(yo + (size_t)(t0 + 16 * (2 * k2 + (fq & 1)) + fr) * D + 16 * vt + 4 * (fq & 2)) = (v4u){sx_[0], sy_[0], sx_[1], sy_[1]}; } }
            GLA_BAR();
        }
#undef GLC_LOADG
    }
    __syncthreads();
}
#undef GLA_BAR

struct RowVals { f32x4 v[4]; };
__device__ __forceinline__ void ln_normalise(RowVals& t, const float* g, const float* bta, int lane) {
    float s = 0.f;
#pragma unroll
    for (int j = 0; j < 4; ++j) s += (t.v[j].x + t.v[j].y) + (t.v[j].z + t.v[j].w);
    const float mean = wave_sum(s) * (1.f / D); float s2 = 0.f;
#pragma unroll
    for (int j = 0; j < 4; ++j) { t.v[j] = t.v[j] - mean; s2 += (t.v[j].x * t.v[j].x + t.v[j].y * t.v[j].y) + (t.v[j].z * t.v[j].z + t.v[j].w * t.v[j].w); }
    const float rstd = frsq(wave_sum(s2) * (1.f / D) + LN_EPS);
#pragma unroll
    for (int j = 0; j < 4; ++j) { const f32x4 gg = *(const f32x4*)(g + 4 * lane + 256 * j), bb = *(const f32x4*)(bta + 4 * lane + 256 * j); t.v[j] = t.v[j] * rstd * gg + bb; }
}
__device__ __forceinline__ void ln_mix_phase(ArgP a, int l, LAS unsigned char* lds, int wg, int tid) {
    const int lane = tid & 63, wave = __builtin_amdgcn_readfirstlane(tid >> 6);
    const bool moe = (l & 1) != 0;
    const float* xin = a->in[I_X];
    const float* mb = (const float*)(a->ws + WS_MOD) + ((size_t)l * BATCH + (wg >> 3)) * NMOD * D;
    unsigned char* h8p = a->ws + WS_H8; unsigned char* r8p = a->ws + WS_R8; float* sap = (float*)(a->ws + WS_SA); const bf16* yp = (const bf16*)a->out;
    LAS float* RW = (LAS float*)lds;
    LAS int* E0 = (LAS int*)(lds + 32768); LAS int* E1 = E0 + 256; LAS int* LP = E1 + 256;
    LAS float* W0 = (LAS float*)(LP + 512); LAS float* W1 = W0 + 256;
    if (moe) { const float* rw = a->in[I_RW] + (size_t)(l >> 1) * D * NE; for (int i = tid; i < D * NE; i += 512) RW[(i & 7) * D + (i >> 3)] = rw[i]; __syncthreads(); }
    f32x4 pGt[4], pG2[4], pB2[4];
    LAS f32x4* PR = (LAS f32x4*)(lds + 40960);
#pragma unroll
    for (int jj = 0; jj < 4; ++jj) { const int o = 8 * lane + 512 * (jj >> 1) + 4 * (jj & 1);
        const f32x4 gt = *(const f32x4*)(mb + 2 * D + o), shf = *(const f32x4*)(mb + 3 * D + o), scf = *(const f32x4*)(mb + 4 * D + o);
        const f32x4 g = *(const f32x4*)(a->in[I_LNMG] + l * D + o), bb = *(const f32x4*)(a->in[I_LNMB] + l * D + o);
        pGt[jj] = gt + 1.0f; pG2[jj] = g * (scf + 1.0f); pB2[jj] = bb * (scf + 1.0f) + shf;
        if (l != 0 && wave == 0) { const f32x4 scm = *(const f32x4*)(mb + 1 * D + o);
            PR[lane + 64 * jj] = (f32x4){frcp(1.f + scm.x), frcp(1.f + scm.y), frcp(1.f + scm.z), frcp(1.f + scm.w)}; PR[256 + lane + 64 * jj] = *(const f32x4*)(mb + 0 * D + o); } }
    __syncthreads();
    f32x4 ax[4], bx[4]; v4u ah[2], bh[2], ay[2], by[2];
    float sa_in = 0.f; if (l != 0 && lane < 32) sa_in = sap[ROW_OF(lane)];
#define LNM_LOAD(X_, H_, Y_, rr_) do { const int Rn = ROW_OF(rr_); const GAS v4u* yr_ = (const GAS v4u*)(yp + (size_t)Rn * D) + lane; \
        if (l == 0) { const GAS f32x4* xr_ = (const GAS f32x4*)(xin + (size_t)Rn * D) + 2 * lane; _Pragma("unroll") for (int jj = 0; jj < 4; ++jj) X_[jj] = xr_[128 * (jj >> 1) + (jj & 1)]; } \
        else { const GAS v2u* hq_ = (const GAS v2u*)(h8p + (size_t)Rn * D) + lane; const GAS v2u* hr_ = (const GAS v2u*)(r8p + (size_t)Rn * D) + lane; \
            _Pragma("unroll") for (int j = 0; j < 2; ++j) { const v2u q_ = hq_[64 * j], r_ = hr_[64 * j]; H_[j] = (v4u){q_.x, q_.y, r_.x, r_.y}; } } \
        _Pragma("unroll") for (int j = 0; j < 2; ++j) Y_[j] = yr_[64 * j]; } while (0)
    LNM_LOAD(ax, ah, ay, 0); LNM_LOAD(bx, bh, by, 1);
    ROW0_LANDED4(pGt); ROW0_LANDED4(pG2); ROW0_LANDED4(pB2);
    if (l == 0) { ROW0_LANDED4(ax); ROW0_LANDED4(bx); } else { ROW0_LANDED2(ah); ROW0_LANDED2(bh); }
    ROW0_LANDED2(ay); ROW0_LANDED2(by); asm volatile("" :: "v"(sa_in));
    float sa_keep = 0.f;
    auto one_row = [&](f32x4 (&X)[4], v4u (&H)[2], v4u (&Y)[2], const int rr, const bool reload) __attribute__((always_inline)) {
        const int R = ROW_OF(rr), rl = R & 255;
        f32x4 tv[4]; float s1 = 0.f;
        const float si = (l != 0) ? rdlane_f(sa_in, rr) : 0.f, si254 = si * (1.0f / 254.0f), sic = -128.0f * si - 128.0f * si254;
#pragma unroll
        for (int j = 0; j < 2; ++j) { f32x4 c0, c1;
            if (l == 0) { c0 = X[2 * j]; c1 = X[2 * j + 1]; }
            else { const v4u hv = H[j];
                c0 = (carrier4(hv.x, hv.z, si, si254, sic) - PR[256 + lane + 64 * (2 * j)]) * PR[lane + 64 * (2 * j)];
                c1 = (carrier4(hv.y, hv.w, si, si254, sic) - PR[256 + lane + 64 * (2 * j + 1)]) * PR[lane + 64 * (2 * j + 1)]; }
            const v4u yv = Y[j];
            tv[2 * j] = c0 * DN_ALPHA + pGt[2 * j] * (f32x4){bflo(yv.x), bfhi(yv.x), bflo(yv.y), bfhi(yv.y)};
            tv[2 * j + 1] = c1 * DN_ALPHA + pGt[2 * j + 1] * (f32x4){bflo(yv.z), bfhi(yv.z), bflo(yv.w), bfhi(yv.w)};
            s1 += ((tv[2 * j].x + tv[2 * j].y) + (tv[2 * j].z + tv[2 * j].w)) + ((tv[2 * j + 1].x + tv[2 * j + 1].y) + (tv[2 * j + 1].z + tv[2 * j + 1].w)); }
        if (reload) LNM_LOAD(X, H, Y, rr + 2);
        const float mean = wave_sum(s1) * (1.f / D); float s2 = 0.f;
#pragma unroll
        for (int j = 0; j < 4; ++j) { tv[j] = tv[j] - mean; s2 += (tv[j].x * tv[j].x + tv[j].y * tv[j].y) + (tv[j].z * tv[j].z + tv[j].w * tv[j].w); }
        const float rstd = frsq(wave_sum(s2) * (1.f / D) + LN_EPS);
        float lgt[NE]; float hmax = 0.f;
#pragma unroll
        for (int e = 0; e < NE; ++e) lgt[e] = 0.f;
#pragma unroll
        for (int j = 0; j < 2; ++j) {
#pragma unroll
            for (int h = 0; h < 2; ++h) { const int jj = 2 * j + h;
                const f32x4 hv = tv[jj] * rstd * pG2[jj] + pB2[jj];
                hmax = __builtin_fmaxf(hmax, __builtin_fmaxf(__builtin_fmaxf(__builtin_fabsf(hv.x), __builtin_fabsf(hv.y)), __builtin_fmaxf(__builtin_fabsf(hv.z), __builtin_fabsf(hv.w))));
                if (moe) { const int kk = 8 * lane + 512 * j + 4 * h;
#pragma unroll
                    for (int e = 0; e < NE; ++e) { const f32x4 r = *(const LAS f32x4*)(RW + e * D + kk); lgt[e] += (hv.x * r.x + hv.y * r.y) + (hv.z * r.z + hv.w * r.w); } } } }
        {
          const float rmax = wave_max_nonneg(hmax), qs = rmax > 0.f ? 127.0f / rmax : 0.f;
          GAS v2u* h8 = (GAS v2u*)(h8p + (size_t)R * D) + lane; GAS v2u* r8 = (GAS v2u*)(r8p + (size_t)R * D) + lane;
#pragma unroll
          for (int j = 0; j < 2; ++j) { const f32x4 h0 = (tv[2 * j] * rstd * pG2[2 * j] + pB2[2 * j]) * qs, h1 = (tv[2 * j + 1] * rstd * pG2[2 * j + 1] + pB2[2 * j + 1]) * qs;
              unsigned q0_, r0_, q1_, r1_; carrier_q4(h0, q0_, r0_); carrier_q4(h1, q1_, r1_); h8[64 * j] = (v2u){q0_, q1_}; r8[64 * j] = (v2u){r0_, r1_}; }
          sa_keep = (lane == rr) ? rmax * (1.0f / 127.0f) : sa_keep; }
        if (moe) {
            const float* rb = a->in[I_RB] + (l >> 1) * NE;
#pragma unroll
            for (int e = 0; e < NE; ++e) lgt[e] = wave_sum(lgt[e]) + rb[e];
            int e0 = 0; float v0 = lgt[0];
#pragma unroll
            for (int e = 1; e < NE; ++e) if (lgt[e] > v0) { v0 = lgt[e]; e0 = e; }
            int e1 = -1; float v1 = -3.0e38f;
#pragma unroll
            for (int e = 0; e < NE; ++e) if (e != e0 && lgt[e] > v1) { v1 = lgt[e]; e1 = e; }
            const float ex = __expf(v1 - v0), w0 = 1.f / (1.f + ex), w1 = ex / (1.f + ex);
            if (lane == 0) { E0[rl] = e0; E1[rl] = e1; W0[rl] = w0; W1[rl] = w1; }
        }
    };
    for (int rr = 0; rr < 30; rr += 2) { one_row(ax, ah, ay, rr, true); one_row(bx, bh, by, rr + 1, true); }
    one_row(ax, ah, ay, 30, false); one_row(bx, bh, by, 31, false);
    if (lane < 32) sap[ROW_OF(lane)] = sa_keep;
    if (moe) {
        __syncthreads();
        if (wave == 0) {
            int run[NE];
#pragma unroll
            for (int e = 0; e < NE; ++e) run[e] = 0;
            for (int q = 0; q < 8; ++q) { const int n = 64 * q + lane; const int e = (n & 1) ? E1[n >> 1] : E0[n >> 1]; int rank = 0;
#pragma unroll
                for (int x = 0; x < NE; ++x) { const unsigned long long mk = __ballot(e == x); const int below = __popcll(mk & ((1ull << lane) - 1ull));
                    if (e == x) rank = run[x] + below; run[x] += __popcll(mk); }
                LP[n] = rank; }
            if (lane < NE) { int cv = 0;
#pragma unroll
                for (int x = 0; x < NE; ++x) cv = (lane == x) ? run[x] : cv;
                ((int*)(a->ws + WS_WGCNT))[wg * NE + lane] = cv; }
        }
        __syncthreads();
        if (tid < 256) { const int R = wg * 256 + tid;
            ((int*)(a->ws + WS_TOKE))[R] = E0[tid] | (E1[tid] << 8); ((int*)(a->ws + WS_TOKP0))[R] = LP[2 * tid]; ((int*)(a->ws + WS_TOKP1))[R] = LP[2 * tid + 1];
            ((float*)(a->ws + WS_TOKW0))[R] = W0[tid]; ((float*)(a->ws + WS_TOKW1))[R] = W1[tid]; }
    }
}
__device__ __forceinline__ void moe_gather_phase(ArgP a, LAS unsigned char* lds, int wg, int tid) {
    const int lane = tid & 63, wave = __builtin_amdgcn_readfirstlane(tid >> 6);
    LAS int* TOTAL = (LAS int*)lds; LAS int* MYB = TOTAL + 8; LAS int* OFF = MYB + 8;
    const int* cnt = (const int*)(a->ws + WS_WGCNT);
    { const int e = wave; int c4[4]; int s = 0;
#pragma unroll
      for (int j = 0; j < 4; ++j) { c4[j] = cnt[(4 * lane + j) * NE + e]; s += c4[j]; }
      int incl = s;
#pragma unroll
      for (int o = 1; o < 64; o <<= 1) { const int t = __shfl_up(incl, o); if (lane >= o) incl += t; }
      const int excl = incl - s; const int total = __shfl(incl, 63);
      int mine = excl;
#pragma unroll
      for (int j = 0; j < 4; ++j) if (j < (wg & 3)) mine += c4[j];
      const int mb = __shfl(mine, wg >> 2);
      if (lane == 0) { TOTAL[e] = total; MYB[e] = mb; } }
    __syncthreads();
    if (tid == 0) { int o = 0; for (int e = 0; e < NE; ++e) { OFF[e] = o; o += (TOTAL[e] + 255) & ~255; }
        if (wg == 0) { int* pt = (int*)(a->ws + WS_PANEL); pt[0] = o >> 8; int p = 0; for (int e = 0; e < NE; ++e) { const int np = (TOTAL[e] + 255) >> 8; for (int i = 0; i < np; ++i) pt[16 + p++] = e; } } }
    __syncthreads();
    int* s2t = (int*)(a->ws + WS_S2T);
    if (wg < NE) { const int e = wg; for (int i = OFF[e] + TOTAL[e] + tid; i < OFF[e] + ((TOTAL[e] + 255) & ~255); i += 512) { s2t[i] = 0; ((float*)(a->ws + WS_SAS))[i] = 0.f; } }
    if (tid < 256) { const int R = wg * 256 + tid;
        const int ee = ((const int*)(a->ws + WS_TOKE))[R], e0 = ee & 255, e1 = ee >> 8;
        const int s0 = OFF[e0] + MYB[e0] + ((const int*)(a->ws + WS_TOKP0))[R], s1 = OFF[e1] + MYB[e1] + ((const int*)(a->ws + WS_TOKP1))[R];
        s2t[s0] = R; s2t[s1] = R; ((int*)(a->ws + WS_TOKP0))[R] = s0; ((int*)(a->ws + WS_TOKP1))[R] = s1;
        const float sr = ((const float*)(a->ws + WS_SA))[R]; ((float*)(a->ws + WS_SAS))[s0] = sr; ((float*)(a->ws + WS_SAS))[s1] = sr; }
}
__device__ __forceinline__ void ln_ffn_phase(ArgP a, int l, LAS unsigned char* lds, int wg, int tid) {
    const int lane = tid & 63, wave = __builtin_amdgcn_readfirstlane(tid >> 6);
    const bool moe = (l & 1) != 0, lastl = !(l + 1 < DEPTH);
    const float* mb = (const float*)(a->ws + WS_MOD) + ((size_t)l * BATCH + (wg >> 3)) * NMOD * D;
    const float* mn = (const float*)(a->ws + WS_MOD) + ((size_t)(lastl ? l : l + 1) * BATCH + (wg >> 3)) * NMOD * D;
    const bf16* fp = (const bf16*)(a->ws + (moe ? WS_F : WS_FD)); unsigned char* h8p = a->ws + WS_H8; unsigned char* r8p = a->ws + WS_R8; float* sap = (float*)(a->ws + WS_SA);
    f32x4 pInv[4], pSh[4], pGt[4], pG2[4], pB2[4];
#pragma unroll
    for (int jj = 0; jj < 4; ++jj) { const int o = 8 * lane + 512 * (jj >> 1) + 4 * (jj & 1);
        const f32x4 scf = *(const f32x4*)(mb + 4 * D + o), gt = *(const f32x4*)(mb + 5 * D + o);
        const f32x4 g = *(const f32x4*)(a->in[I_LNFG] + l * D + o), bb = *(const f32x4*)(a->in[I_LNFB] + l * D + o);
        pInv[jj] = (f32x4){frcp(1.f + scf.x), frcp(1.f + scf.y), frcp(1.f + scf.z), frcp(1.f + scf.w)}; pSh[jj] = *(const f32x4*)(mb + 3 * D + o); pGt[jj] = gt + 1.0f;
        if (lastl) { pG2[jj] = g; pB2[jj] = bb; }
        else { const f32x4 scn = *(const f32x4*)(mn + 1 * D + o), shn = *(const f32x4*)(mn + 0 * D + o); pG2[jj] = g * (scn + 1.0f); pB2[jj] = bb * (scn + 1.0f) + shn; } }
    int ms0 = 0, ms1 = 0; float mw0 = 1.f; float sa_in = 0.f;
    { const int Rl = ROW_OF(lane & 31); ms0 = Rl; ms1 = Rl; sa_in = sap[Rl];
      if (moe) { ms0 = ((const int*)(a->ws + WS_TOKP0))[Rl]; ms1 = ((const int*)(a->ws + WS_TOKP1))[Rl]; mw0 = ((const float*)(a->ws + WS_TOKW0))[Rl]; } }
    v4u ah[2], af0[2], af1[2], bh[2], bf0[2], bf1[2];
#define LNF_LOAD(H_, F0_, F1_, rr_) do { const int Rn = ROW_OF(rr_); const int s0n = rdlane_i(ms0, (rr_)), s1n = rdlane_i(ms1, (rr_)); \
        const GAS v2u* hq_ = (const GAS v2u*)(h8p + (size_t)Rn * D) + lane; const GAS v2u* hr_ = (const GAS v2u*)(r8p + (size_t)Rn * D) + lane; const GAS v4u* f0_ = (const GAS v4u*)(fp + (size_t)s0n * D) + lane; const GAS v4u* f1_ = (const GAS v4u*)(fp + (size_t)s1n * D) + lane; \
        _Pragma("unroll") for (int j = 0; j < 2; ++j) { const v2u q_ = hq_[64 * j], r_ = hr_[64 * j]; H_[j] = (v4u){q_.x, q_.y, r_.x, r_.y}; F0_[j] = f0_[64 * j]; if (moe) F1_[j] = f1_[64 * j]; } } while (0)
#define LNF_UNP(w_, h_) ((h_) == 0 ? (f32x4){bflo((w_).x), bfhi((w_).x), bflo((w_).y), bfhi((w_).y)} : (f32x4){bflo((w_).z), bfhi((w_).z), bflo((w_).w), bfhi((w_).w)})
    LNF_LOAD(ah, af0, af1, 0); LNF_LOAD(bh, bf0, bf1, 1);
    ROW0_LANDED4(pInv); ROW0_LANDED4(pSh); ROW0_LANDED4(pGt); ROW0_LANDED4(pG2); ROW0_LANDED4(pB2); asm volatile("" :: "v"(ms0), "v"(ms1), "v"(mw0), "v"(sa_in));
    ROW0_LANDED2(ah); ROW0_LANDED2(af0); ROW0_LANDED2(bh); ROW0_LANDED2(bf0); if (moe) { ROW0_LANDED2(af1); ROW0_LANDED2(bf1); }
    float sa_keep = 0.f;
    auto one_row = [&](v4u (&H)[2], v4u (&F0)[2], v4u (&F1)[2], const int rr, const bool reload) __attribute__((always_inline)) {
        const int R = ROW_OF(rr);
        const float w0 = rdlane_f(mw0, rr), w1 = 1.0f - w0;
        const float si = rdlane_f(sa_in, rr), si254 = si * (1.0f / 254.0f), sic = -128.0f * si - 128.0f * si254;
        f32x4 tv[4];
        float s1 = 0.f;
#pragma unroll
        for (int jj = 0; jj < 4; ++jj) { const int j = jj >> 1, h = jj & 1; f32x4 fv = LNF_UNP(F0[j], h) * w0;
            if (moe) fv += LNF_UNP(F1[j], h) * w1;
            const f32x4 xv = (carrier4(h == 0 ? H[j].x : H[j].y, h == 0 ? H[j].z : H[j].w, si, si254, sic) - pSh[jj]) * pInv[jj];
            tv[jj] = xv * DN_ALPHA + pGt[jj] * fv; s1 += (tv[jj].x + tv[jj].y) + (tv[jj].z + tv[jj].w); }
        if (reload) LNF_LOAD(H, F0, F1, rr + 2);
        const float mean = wave_sum(s1) * (1.f / D); float s2 = 0.f;
#pragma unroll
        for (int j = 0; j < 4; ++j) { tv[j] = tv[j] - mean; s2 += (tv[j].x * tv[j].x + tv[j].y * tv[j].y) + (tv[j].z * tv[j].z + tv[j].w * tv[j].w); }
        const float rstd = frsq(wave_sum(s2) * (1.f / D) + LN_EPS);
        if (!lastl) { float hmax = 0.f;
#pragma unroll
            for (int j = 0; j < 4; ++j) { const f32x4 hv = tv[j] * rstd * pG2[j] + pB2[j];
                hmax = __builtin_fmaxf(hmax, __builtin_fmaxf(__builtin_fmaxf(__builtin_fabsf(hv.x), __builtin_fabsf(hv.y)), __builtin_fmaxf(__builtin_fabsf(hv.z), __builtin_fabsf(hv.w)))); }
            const float rmax = wave_max_nonneg(hmax), qs = rmax > 0.f ? 127.0f / rmax : 0.f;
            GAS v2u* h8 = (GAS v2u*)(h8p + (size_t)R * D) + lane; GAS v2u* r8 = (GAS v2u*)(r8p + (size_t)R * D) + lane;
#pragma unroll
            for (int j = 0; j < 2; ++j) { unsigned q0_, r0_, q1_, r1_;
                carrier_q4((tv[2 * j] * rstd * pG2[2 * j] + pB2[2 * j]) * qs, q0_, r0_); carrier_q4((tv[2 * j + 1] * rstd * pG2[2 * j + 1] + pB2[2 * j + 1]) * qs, q1_, r1_);
                h8[64 * j] = (v2u){q0_, q1_}; r8[64 * j] = (v2u){r0_, r1_}; }
            sa_keep = (lane == rr) ? rmax * (1.0f / 127.0f) : sa_keep; }
        else { GAS f32x4* xo = (GAS f32x4*)(a->out + (size_t)R * D) + 2 * lane;
#pragma unroll
            for (int jj = 0; jj < 4; ++jj) xo[128 * (jj >> 1) + (jj & 1)] = tv[jj] * rstd * pG2[jj] + pB2[jj]; }
    };
    for (int rr = 0; rr < 30; rr += 2) { one_row(ah, af0, af1, rr, true); one_row(bh, bf0, bf1, rr + 1, true); }
    one_row(ah, af0, af1, 30, false); one_row(bh, bf0, bf1, 31, false);
    if (!lastl && lane < 32) sap[ROW_OF(lane)] = sa_keep;
#undef LNF_LOAD
#undef LNF_UNP
}

__device__ __forceinline__ void grid_bar_now(LAS unsigned char* lds) { if (MK_N_LAUNCHES == 1) { XcdBarrier b_; b_.bar = (unsigned*)(argp()->ws + WS_CTL) + CW_BAR; b_.x = xb_xcc_id(); b_.st = (volatile LAS unsigned*)(lds + MISC_OFF) + 8; xcd_barrier(b_); } }
#define REP_LOOP(k) for (int rep_ = 0; rep_ < REPS(k); ++rep_, (rep_ < REPS(k) ? grid_bar_now(lds) : (void)0))
#define STEP_IN (lo <= step && step < hi)
#define STEP_END do { if (MK_N_LAUNCHES == 1 && STEP_IN && step + 1 < hi) { XcdBarrier b_; b_.bar = (unsigned*)(argp()->ws + WS_CTL) + CW_BAR; b_.x = xb_xcc_id(); b_.st = (volatile LAS unsigned*)(lds + MISC_OFF) + 8; xcd_barrier(b_); } ++step; } while (0)
#define PHASE_IDS const int tid = wave_id_ * 64 + lane_id_volatile(), wg = opaque_s((int)blockIdx.x), G = opaque_s((int)gridDim.x); (void)tid; (void)wg; (void)G
template <int l> __device__ __forceinline__ void layer_steps(LAS unsigned char* lds, const int lo, const int hi, int& step, const int wave_id_) {
        constexpr bool moe = (l & 1) != 0;
        if (PH(2) && STEP_IN) REP_LOOP(2) {
            PHASE_IDS; ArgP ap = argp(); unsigned char* ws = ap->ws;
            const pg8::Gemm g = pg8::mk_gemm(D / 2, D / 2, D / 2);
            pg8::SchedPlain S{(const char*)(ws + WS_H8), (const char*)(ws + WS_WIN) + (size_t)l * NIN * D * 2, M / 256, NIN / 256, G, wg, 256u * D, 256u * D};
            pg8::EpiInProj E{ws, ap->in[I_BALPHA] + l * GDK, (const float*)(ws + WS_SA), (const float*)(ws + WS_SWIN) + l * NIN};
            pg8::gemm_phase<pg8::EpiInProj, pg8::SchedPlain, true, true, false, false, true>(lds, g, S, E, tid);
        }
        STEP_END;
        if (PH(3) && STEP_IN) REP_LOOP(3) {
            PHASE_IDS; ArgP ap = argp(); unsigned char* ws = ap->ws;
            const pg8::Gemm g = pg8::mk_gemm(S5KU, S5LDA, S5KU); pg8::SchedGroup S{(const char*)(ws + WS_AEXT), (const char*)(ws + WS_CTRL) + (size_t)l * S5G * 256 * S5KU * 2, S5G * 8, 1, G, wg, 256u * S5LDA * 2, 0u, 256u * S5KU * 2};
            pg8::EpiS1 E{(bf16*)(ws + WS_SLOC)};
            pg8::gemm_phase<pg8::EpiS1, pg8::SchedGroup>(lds, g, S, E, tid);
            pg8::Unit u0;
            if (S.next(0, u0)) {
                __builtin_amdgcn_fence(__ATOMIC_ACQUIRE, "agent"); asm volatile("s_waitcnt vmcnt(0)" ::: "memory"); __syncthreads();
                if (tid < 256) {
                    const int p = tid & 63, grp = u0.pm >> 3, r0 = u0.pm * 256 + (tid >> 6) * S5NC;
                    const float* lt = (const float*)(ws + WS_LAMT) + ((size_t)(l * S5G + grp) * S5P + p) * 2; const float lr = lt[0], li = lt[1];
                    const bf16* sloc = (const bf16*)(ws + WS_SLOC) + (size_t)r0 * 128;
                    bf16* ae = (bf16*)(ws + WS_AEXT) + (size_t)r0 * S5LDA + S5KU;
                    float hr = 0.f, hi_ = 0.f;
                    static_assert(S5NC == 64, "carry scan batches");
                    float sra[32], sia[32], srb[32], sib[32];
#pragma unroll
                    for (int c = 0; c < 32; ++c) { sra[c] = bflo((unsigned)sloc[(size_t)c * 128 + p]); sia[c] = bflo((unsigned)sloc[(size_t)c * 128 + 64 + p]); }
#pragma unroll
                    for (int c = 0; c < 32; ++c) { srb[c] = bflo((unsigned)sloc[(size_t)(32 + c) * 128 + p]); sib[c] = bflo((unsigned)sloc[(size_t)(32 + c) * 128 + 64 + p]); }
#pragma unroll
                    for (int c = 0; c < 32; ++c) { ae[(size_t)c * S5LDA + p] = (bf16)f2bf(hr); ae[(size_t)c * S5LDA + 64 + p] = (bf16)f2bf(hi_);
                        const float nr = lr * hr - li * hi_ + sra[c], ni = lr * hi_ + li * hr + sia[c]; hr = nr; hi_ = ni; }
#pragma unroll
                    for (int c = 0; c < 32; ++c) { ae[(size_t)(32 + c) * S5LDA + p] = (bf16)f2bf(hr); ae[(size_t)(32 + c) * S5LDA + 64 + p] = (bf16)f2bf(hi_);
                        const float nr = lr * hr - li * hi_ + srb[c], ni = lr * hi_ + li * hr + sib[c]; hr = nr; hi_ = ni; }
                }
            }
        }
        STEP_END;
        if (STEP_IN) REP_LOOP(5) {
            PHASE_IDS;
            if (wg < 128) { if (PH(5)) for (int gr_ = 0; gr_ < GLA_REPS; ++gr_) gla_phase(argp(), l, lds, wg, tid); }
            else if (PH(6)) {
                { ArgP ap = argp(); unsigned char* ws = ap->ws;
                  const pg8::Gemm g = pg8::mk_gemm(S5LDA, S5LDA, S5LDA); pg8::SchedGroupS5 S{(const char*)(ws + WS_AEXT), (const char*)(ws + WS_TOEP) + (size_t)l * S5G * S5KU * S5LDA * 2, S5G * 8, 2, G - 128, wg - 128, 256u * S5LDA * 2, 256u * S5LDA * 2, (unsigned)S5KU * S5LDA * 2};
                  pg8::EpiS5 E{(const bf16*)(ws + WS_AEXT), ap->in[I_SD] + l * S5W, (bf16*)(ws + WS_YS5)};
                  pg8::gemm_phase<pg8::EpiS5, pg8::SchedGroupS5>(lds, g, S, E, tid); }
                { unsigned* ctl = (unsigned*)(argp()->ws + WS_CTL); sub_barrier(ctl + CW_SUB + 64 * l, (unsigned)(G - 128), ctl + CW_BAR); }
                { const int tid2 = wave_id_ * 64 + lane_id_volatile(), wg2 = opaque_s(wg), G2 = opaque_s(G); ArgP ap = argp(); unsigned char* ws = ap->ws;
                  const pg8::Gemm g{S5W, 32u, (unsigned)M * 32u, 4u * (unsigned)M * 32u, (unsigned)S5W};
                  pg8::SchedPlain S{(const char*)(ws + WS_YS5), (const char*)(ws + WS_WGLU) + (size_t)l * S5W * S5W * 2, M / 256, 2, G2 - 128, wg2 - 128, 256u * 32u, 256u * S5W * 2};
                  pg8::EpiGlu E{(const bf16*)(ws + WS_YS5), ap->in[I_BGLU] + l * S5W, (bf16*)(ws + WS_YCAT)};
                  pg8::gemm_phase<pg8::EpiGlu, pg8::SchedPlain>(lds, g, S, E, tid2); }
            }
        }
        STEP_END;
        if (PH(8) && STEP_IN) REP_LOOP(8) {
            PHASE_IDS; ArgP ap = argp(); unsigned char* ws = ap->ws;
            const pg8::Gemm g = pg8::mk_gemm(D, D, D); pg8::SchedPlain S{(const char*)(ws + WS_YCAT), (const char*)(ws + WS_WOUT) + (size_t)l * D * D * 2, M / 256, 4, G, wg, 256u * D * 2, 256u * D * 2};
            pg8::EpiPlain E{(bf16*)ap->out, D, 1.0f};
            pg8::gemm_phase<pg8::EpiPlain, pg8::SchedPlain>(lds, g, S, E, tid);
        }
        STEP_END;
        if (PH(9) && STEP_IN) { PHASE_IDS; ln_mix_phase(argp(), l, lds, wg, tid); }
        STEP_END;
        if constexpr (moe) {
            if (PH(10) && STEP_IN) { PHASE_IDS; moe_gather_phase(argp(), lds, wg, tid); }
            STEP_END;
            if (PH(11) && STEP_IN) REP_LOOP(13) {
                PHASE_IDS; ArgP ap = argp(); unsigned char* ws = ap->ws;
                const int npan = __builtin_amdgcn_readfirstlane(((const int*)(ws + WS_PANEL))[0]);
                const pg8::Gemm g = pg8::mk_gemm(D / 2, D / 2, D / 2);
                pg8::SchedExpert S{(const char*)(ws + WS_H8), (const char*)(ws + WS_WMOE), (const int*)(ws + WS_PANEL) + 16, 0, npan - 256, DFF / 128, G, wg, 256u * D, 256u * D, (unsigned)WMOE_E, 0, (const int*)(ws + WS_S2T), 0, 0};
                pg8::EpiGateUpI8 E{ws + WS_ACT, 0, (const float*)(ws + WS_SAS), (const int*)(ws + WS_S2T), (const float*)(ws + WS_SW) + 2 * DFF, (const int*)(ws + WS_PANEL) + 16};
                pg8::gemm_phase<pg8::EpiGateUpI8, pg8::SchedExpert, true, true, false, true, true>(lds, g, S, E, tid);
            }
            STEP_END;
            if (PH(12) && STEP_IN) REP_LOOP(14) {
                PHASE_IDS;
                { ArgP ap = argp(); unsigned char* ws = ap->ws;
                  const int npan = __builtin_amdgcn_readfirstlane(((const int*)(ws + WS_PANEL))[0]);
                  const pg8::Gemm g = pg8::mk_gemm(DFF / 2, DFF / 2, DFF / 2);
                  pg8::SchedExpert S{(const char*)(ws + WS_ACT), (const char*)(ws + WS_WMOE) + WMOE_D, (const int*)(ws + WS_PANEL) + 16, 0, npan - 256, D / 256, G, wg, 256u * DFF, 256u * DFF, (unsigned)WMOE_E, 1, nullptr, 0, 0};
                  pg8::EpiPlain E{(bf16*)(ws + WS_F), D, 1.0f / (pg8::ACT_SCALE * pg8::WD_SCALE)};
                  pg8::gemm_phase<pg8::EpiPlain, pg8::SchedExpert, true, true, true>(lds, g, S, E, tid); }
                { const int tid2 = wave_id_ * 64 + lane_id_volatile(), wg2 = opaque_s(wg), G2 = opaque_s(G); ArgP ap = argp(); unsigned char* ws = ap->ws;
                  const int npan = __builtin_amdgcn_readfirstlane(((const int*)(ws + WS_PANEL))[0]);
                  const int nb5 = 4 * (npan - 256) - 4 * G2;
                  const pg8::Gemm g = pg8::mk_gemm(D / 2, D / 2, D / 2);
                  pg8::SchedExpert S{(const char*)(ws + WS_H8), (const char*)(ws + WS_WMOE), (const int*)(ws + WS_PANEL) + 16, npan - 256, 256, DFF / 128, G2, wg2, 256u * D, 256u * D, (unsigned)WMOE_E, 0, (const int*)(ws + WS_S2T), nb5 > 0 ? nb5 : 0, DFF / 128 - 2};
                  pg8::EpiGateUpI8 E{(unsigned char*)ap->out, npan - 256, (const float*)(ws + WS_SAS), (const int*)(ws + WS_S2T), (const float*)(ws + WS_SW) + 2 * DFF, (const int*)(ws + WS_PANEL) + 16};
                  pg8::gemm_phase<pg8::EpiGateUpI8, pg8::SchedExpert, true, true, false, true, true>(lds, g, S, E, tid2); }
            }
            STEP_END;
            if (PH(12) && STEP_IN) REP_LOOP(15) {
                PHASE_IDS; ArgP ap = argp(); unsigned char* ws = ap->ws;
                const int npan = __builtin_amdgcn_readfirstlane(((const int*)(ws + WS_PANEL))[0]);
                const pg8::Gemm g = pg8::mk_gemm(DFF / 2, DFF / 2, DFF / 2);
                pg8::SchedExpert S{(const char*)ap->out, (const char*)(ws + WS_WMOE) + WMOE_D, (const int*)(ws + WS_PANEL) + 16, npan - 256, 256, D / 256, G, wg, 256u * DFF, 256u * DFF, (unsigned)WMOE_E, 1, nullptr, 0, 0};
                pg8::EpiPlain E{(bf16*)(ws + WS_F), D, 1.0f / (pg8::ACT_SCALE * pg8::WD_SCALE)};
                pg8::gemm_phase<pg8::EpiPlain, pg8::SchedExpert, true, true, true>(lds, g, S, E, tid);
            }
            STEP_END;
            if (PH(13) && STEP_IN) { PHASE_IDS; ln_ffn_phase(argp(), l, lds, wg, tid); }
            STEP_END;
        } else {
            if (PH(11) && STEP_IN) REP_LOOP(11) {
                PHASE_IDS; ArgP ap = argp(); unsigned char* ws = ap->ws;
                const pg8::Gemm g = pg8::mk_gemm(D / 2, D / 2, D / 2);
                pg8::SchedExpert S{(const char*)(ws + WS_H8), (const char*)(ws + WS_WDEN), nullptr, 0, M / 256, DFF / 128, G, wg, 256u * D, 256u * D, 0u, 0, nullptr, 0, 0};
                pg8::EpiGateUpI8 E{ws + WS_F, 0, (const float*)(ws + WS_SA), nullptr, (const float*)(ws + WS_SW), nullptr};
                pg8::gemm_phase<pg8::EpiGateUpI8, pg8::SchedExpert, true, true, false, false, true>(lds, g, S, E, tid);
            }
            STEP_END;
            if (PH(12) && STEP_IN) REP_LOOP(12) {
                PHASE_IDS; ArgP ap = argp(); unsigned char* ws = ap->ws;
                const pg8::Gemm g = pg8::mk_gemm(DFF / 2, DFF / 2, DFF / 2);
                pg8::SchedExpert S{(const char*)(ws + WS_F), (const char*)(ws + WS_WDEN) + WMOE_D, nullptr, 0, M / 256, D / 256, G, wg, 256u * DFF, 256u * DFF, 0u, 1, nullptr, 0, 0};
                pg8::EpiPlain E{(bf16*)(ws + WS_FD), D, 1.0f / (pg8::ACT_SCALE * pg8::WD_SCALE)};
                pg8::gemm_phase<pg8::EpiPlain, pg8::SchedExpert, true, true, true>(lds, g, S, E, tid);
            }
            STEP_END;
            if (PH(13) && STEP_IN) { PHASE_IDS; ln_ffn_phase(argp(), l, lds, wg, tid); }
            STEP_END;
        }
    }

__global__ void __launch_bounds__(NWAVES * 64, 2) fwd(Args args) {
    extern __shared__ __attribute__((aligned(16))) unsigned char lds_raw[];
    LAS unsigned char* lds = (LAS unsigned char*)lds_raw;
    for (int u = threadIdx.x; u < (LDS_BYTES - LDSCTL_OFF) / 4; u += NWAVES * 64) ((LAS unsigned*)(lds + LDSCTL_OFF))[u] = 0u;
    __syncthreads();
    if (MK_N_LAUNCHES == 1) (void)xcd_barrier_post((unsigned*)(argp()->ws + WS_CTL) + CW_BAR, (volatile LAS unsigned*)(lds + MISC_OFF) + 8);
    const int lo = args.lo, hi = args.hi;
    int step = 0;
    const int wave_id_ = opaque_s(__builtin_amdgcn_readfirstlane((int)threadIdx.x >> 6));

    if (PH(1) && STEP_IN) REP_LOOP(1) {
        PHASE_IDS; const int lane = tid & 63, wave = __builtin_amdgcn_readfirstlane(tid >> 6); ArgP ap = argp(); unsigned char* ws = ap->ws;
        unsigned* ctl = (unsigned*)(ws + WS_CTL);
        for (int r_ = 0; r_ < REPS(16); ++r_) { prologue_mod(ap, lds, wg, G, tid);
        prologue_comb(ap, lds, wg, tid); }
        asm volatile("s_waitcnt vmcnt(0)" ::: "memory"); __syncthreads();
        if (tid == 0) { __builtin_amdgcn_fence(__ATOMIC_RELEASE, "agent"); asm volatile("s_waitcnt vmcnt(0)" ::: "memory"); (void)xb_add(ctl + CW_SUB + 64 * 4, 1u); }
        for (int r_ = 0; r_ < REPS(17); ++r_) if (wg < 2 * S5G) prologue_s5(ap, lds, wg, tid);
        for (int r_ = 0; r_ < REPS(18); ++r_) prologue_strips(ap, lds, wg, G, wave, lane);
        const int nslots = (2 * (G - 64) + 64) * NWAVES;
        for (int r_ = 0; r_ < REPS(19); ++r_) if (wg < 64) prologue_transposes(ap, lds, wg * NWAVES + wave, -1, nslots, wave, lane);
        else prologue_transposes(ap, lds, (64 + 2 * (wg - 64)) * NWAVES + wave, (65 + 2 * (wg - 64)) * NWAVES + wave, nslots, wave, lane);
        if (tid == 0) { XB_SPIN(xb_ld(ctl + CW_SUB + 64 * 4) < (unsigned)G, ctl + CW_BAR); __builtin_amdgcn_fence(__ATOMIC_ACQUIRE, "agent"); asm volatile("s_waitcnt vmcnt(0)" ::: "memory"); }
        __syncthreads();
        for (int r_ = 0; r_ < REPS(20); ++r_) hmod_rows(ap->in[I_X], (const float*)(ws + WS_MOD), 0, D, (bf16*)(ws + WS_HMOD), ws, wg, wave, lane);
    }
    STEP_END;

    layer_steps<0>(lds, lo, hi, step, wave_id_);
    layer_steps<1>(lds, lo, hi, step, wave_id_);
}
#undef STEP_IN
#undef STEP_END

constexpr int N_STEPS = 1 + (5 + 3) + (5 + 1 + 3 + 1);

extern "C" void kernel_launch(void* const* d_in, const int* in_sizes, int n_in, void* d_out, int out_size, void* d_ws, size_t ws_size, hipStream_t stream) {
    static int grid = 0;
    if (grid == 0) {
        if (n_in != 31 || in_sizes[0] != M * D || out_size != M * D || ws_size < WS_END) { fprintf(stderr, "kernel_launch: unexpected shapes / workspace (n_in %d, ws %zu); nothing launched\n", n_in, ws_size); grid = -1; return; }
        int dev = 0, cus = 0, per_cu = 0;
        if (hipGetDevice(&dev) != hipSuccess || hipDeviceGetAttribute(&cus, hipDeviceAttributeMultiprocessorCount, dev) != hipSuccess) { grid = -1; return; }
        if (hipFuncSetAttribute((const void*)fwd, hipFuncAttributeMaxDynamicSharedMemorySize, LDS_BYTES) != hipSuccess) { fprintf(stderr, "kernel_launch: hipFuncSetAttribute failed\n"); grid = -1; return; }
        if (hipOccupancyMaxActiveBlocksPerMultiprocessor(&per_cu, (const void*)fwd, NWAVES * 64, LDS_BYTES) != hipSuccess || per_cu < 1) fprintf(stderr, "kernel_launch: occupancy query reports %d\n", per_cu);
        (void)hipGetLastError();
        grid = cus;
        if (grid != 256) { fprintf(stderr, "kernel_launch: built for 256 CUs, found %d\n", cus); grid = -1; return; }
    }
    if (grid < 0) return;
    if (hipMemsetAsync((char*)d_ws + WS_CTL, 0, CTL_ZERO_BYTES, stream) != hipSuccess) return;
    Args a{};
    for (int i = 0; i < 31; ++i) a.in[i] = (const float*)d_in[i];
    a.out = (float*)d_out; a.ws = (unsigned char*)d_ws;
    if (MK_N_LAUNCHES == 1) { a.lo = 0; a.hi = N_STEPS; hipLaunchKernelGGL(fwd, dim3(grid), dim3(NWAVES * 64), LDS_BYTES, stream, a); }
    else for (int s = 0; s < N_STEPS; ++s) { a.lo = s; a.hi = s + 1; hipLaunchKernelGGL(fwd, dim3(grid), dim3(NWAVES * 64), LDS_BYTES, stream, a); }
}
```
